# Optimizing an MI355X kernel written in HIP

```python
import math
import jax, jax.numpy as jnp
from jax import lax
import numpy as np

D_MODEL = 2048
BATCH = 4
SEQ = 2048
DEPTH = 2

HEAD_DIM = 128
ROPE_THETA = 10000.0
EPS = 1e-6
RET_HEADS = 8
RET_CHUNK = 128
NSA_HEADS = 8
NSA_KV_HEADS = 2
NSA_GROUP = NSA_HEADS // NSA_KV_HEADS
CMP_BLOCK = 32
CMP_STRIDE = 16
SLC_BLOCK = 64
SLC_TOPK = 16
N_LOCAL_BLOCKS = 2
WINDOW = 512
SLC_Q_BLOCK = 64
WIN_Q_BLOCK = 128
DIFF_HEADS = 8
DIFF_V_DIM = 2 * HEAD_DIM
ATTN_Q_BLOCK = 128

RET_WIDTH = RET_HEADS * HEAD_DIM
NSA_WIDTH = NSA_HEADS * HEAD_DIM
NSA_KV_WIDTH = NSA_KV_HEADS * HEAD_DIM
AB_IN_COLS = 4 * RET_WIDTH + 2 * NSA_WIDTH + 6 * NSA_KV_WIDTH + 3 * NSA_HEADS
AB_OUT_WIDTH = RET_WIDTH + NSA_WIDTH
DIFF_QK_WIDTH = DIFF_HEADS * 2 * HEAD_DIM
DIFF_WIDTH = DIFF_HEADS * DIFF_V_DIM
C_IN_COLS = 2 * DIFF_QK_WIDTH + 2 * DIFF_WIDTH

kernel_name = "hybrid_retention_nsa_diffattn"


def rms_norm(x, g):
    xf = x.astype(jnp.float32)
    y = xf * lax.rsqrt(jnp.mean(xf * xf, axis=-1, keepdims=True) + EPS)
    return (y * g.astype(jnp.float32)).astype(x.dtype)


def head_rms(x):
    xf = x.astype(jnp.float32)
    return (xf * lax.rsqrt(jnp.mean(xf * xf, axis=-1, keepdims=True) + EPS)).astype(x.dtype)


def rope_tables(pos):
    inv = 1.0 / (ROPE_THETA ** (jnp.arange(0, HEAD_DIM, 2, dtype=jnp.float32) / HEAD_DIM))
    ang = pos.astype(jnp.float32)[:, None] * inv[None, :]
    return jnp.cos(ang), jnp.sin(ang)


def apply_rope(x, cos, sin):
    half = x.shape[-1] // 2
    x1, x2 = x[..., :half], x[..., half:]
    c = cos.astype(x.dtype)
    s = sin.astype(x.dtype)
    return jnp.concatenate([x1 * c - x2 * s, x1 * s + x2 * c], axis=-1)


def masked_softmax(s, mask):
    s = jnp.where(mask, s.astype(jnp.float32), -1e30)
    return jax.nn.softmax(s, axis=-1)


def to_heads(t, n_heads):
    B, S, _ = t.shape
    return t.reshape(B, S, n_heads, HEAD_DIM).transpose(0, 2, 1, 3)


def retention(q, k, v):
    B, H, S, Dh = q.shape
    C = RET_CHUNK
    N = S // C
    dt = q.dtype
    log_g = jnp.log1p(-jnp.exp2(-5.0 - jnp.arange(H, dtype=jnp.float32)))
    j = jnp.arange(C, dtype=jnp.float32)
    diff = j[:, None] - j[None, :]
    intra = jnp.where(diff >= 0, jnp.exp(log_g[:, None, None] * jnp.maximum(diff, 0.0)), 0.0)
    q_dec = jnp.exp(log_g[:, None] * (j + 1.0))
    k_dec = jnp.exp(log_g[:, None] * (C - 1.0 - j))
    chunk_dec = jnp.exp(log_g * C)
    k = k * (Dh ** -0.5)
    qc = q.reshape(B, H, N, C, Dh)
    kc = k.reshape(B, H, N, C, Dh)
    vc = v.reshape(B, H, N, C, Dh)
    scores = jnp.einsum('bhnid,bhnjd->bhnij', qc, kc) * intra[:, None].astype(dt)
    inner = jnp.einsum('bhnij,bhnjd->bhnid', scores, vc)
    kv = jnp.einsum('bhnjd,bhnje->bhnde', kc * k_dec[:, None, :, None].astype(dt), vc)

    def step(state, kv_n):
        return state * chunk_dec[None, :, None, None] + kv_n, state

    init = jnp.zeros((B, H, Dh, Dh), jnp.float32)
    _, prev = lax.scan(step, init, jnp.moveaxis(kv, 2, 0).astype(jnp.float32))
    prev = jnp.moveaxis(prev, 0, 2).astype(dt)
    cross = jnp.einsum('bhnid,bhnde->bhnie', qc * q_dec[:, None, :, None].astype(dt), prev)
    return (inner + cross).reshape(B, H, S, Dh)


def nsa_compress(t, pe, w1, w2):
    B, G, S, D = t.shape
    n_cmp = (S - CMP_BLOCK) // CMP_STRIDE + 1
    idx = np.arange(n_cmp)[:, None] * CMP_STRIDE + np.arange(CMP_BLOCK)[None, :]
    blocks = (t[:, :, idx] + pe).reshape(B, G, n_cmp, CMP_BLOCK * D)
    return jax.nn.silu(blocks @ w1) @ w2


def nsa(qg, kc_raw, vc_raw, ks, vs, kw, vw, k_g, pe_k, w1_k, w2_k, pe_v, w1_v, w2_v, cos, sin):
    B, G, R, S, D = qg.shape
    dt = qg.dtype
    scale = HEAD_DIM ** -0.5
    t = jnp.arange(S)
    n_cmp = (S - CMP_BLOCK) // CMP_STRIDE + 1
    cmp_end = jnp.arange(n_cmp) * CMP_STRIDE + CMP_BLOCK - 1
    cos_c, sin_c = rope_tables(cmp_end)
    k_cmp = apply_rope(rms_norm(nsa_compress(kc_raw, pe_k, w1_k, w2_k), k_g), cos_c, sin_c)
    v_cmp = nsa_compress(vc_raw, pe_v, w1_v, w2_v)
    cmask = cmp_end[None, :] <= t[:, None]
    s_cmp = jnp.einsum('bgrsd,bgnd->bgrsn', qg, k_cmp) * scale
    p_cmp = masked_softmax(s_cmp, cmask) * cmask
    o_cmp = jnp.einsum('bgrsn,bgnd->bgrsd', p_cmp.astype(dt), v_cmp)
    n_slc = S // SLC_BLOCK
    c_start = np.arange(n_cmp) * CMP_STRIDE
    s_start = np.arange(n_slc) * SLC_BLOCK
    overlap = jnp.asarray(((c_start[:, None] <= s_start[None, :] + SLC_BLOCK - 1)
                           & (c_start[:, None] + CMP_BLOCK - 1 >= s_start[None, :])).astype(np.float32))
    imp = jnp.einsum('bgrsn,nm->bgsm', p_cmp, overlap)
    blk_t = t // SLC_BLOCK
    jb = jnp.arange(n_slc)
    back = blk_t[:, None] - jb[None, :]
    forced = (jb[None, :] == 0) | ((back >= 0) & (back < N_LOCAL_BLOCKS))
    causal_blk = back >= 0
    score = jnp.where(forced, 1e9, jnp.where(causal_blk, imp, -1e9))
    k_top = min(SLC_TOPK, n_slc)
    _, sel = lax.top_k(score, k_top)
    kb = ks.reshape(B, G, n_slc, SLC_BLOCK, D)
    vb = vs.reshape(B, G, n_slc, SLC_BLOCK, D)
    gather = jax.vmap(jax.vmap(lambda blocks, ids: blocks[ids]))

    def slc_block(q0):
        qb = lax.dynamic_slice_in_dim(qg, q0, SLC_Q_BLOCK, axis=3)
        ib = lax.dynamic_slice_in_dim(sel, q0, SLC_Q_BLOCK, axis=2)
        kg = gather(kb, ib).reshape(B, G, SLC_Q_BLOCK, k_top * SLC_BLOCK, D)
        vg = gather(vb, ib).reshape(B, G, SLC_Q_BLOCK, k_top * SLC_BLOCK, D)
        kpos = (ib[..., None] * SLC_BLOCK + jnp.arange(SLC_BLOCK)).reshape(B, G, SLC_Q_BLOCK, k_top * SLC_BLOCK)
        qpos = q0 + jnp.arange(SLC_Q_BLOCK)
        mask = kpos <= qpos[None, None, :, None]
        s = jnp.einsum('bgrqd,bgqkd->bgrqk', qb, kg) * scale
        p = masked_softmax(s, mask[:, :, None])
        return jnp.einsum('bgrqk,bgqkd->bgrqd', p.astype(dt), vg)

    o_slc = lax.map(slc_block, jnp.arange(0, S, SLC_Q_BLOCK))
    o_slc = jnp.moveaxis(o_slc, 0, 3).reshape(B, G, R, S, D)
    kwp = jnp.pad(kw, ((0, 0), (0, 0), (WINDOW, 0), (0, 0)))
    vwp = jnp.pad(vw, ((0, 0), (0, 0), (WINDOW, 0), (0, 0)))

    def win_block(q0):
        qb = lax.dynamic_slice_in_dim(qg, q0, WIN_Q_BLOCK, axis=3)
        kband = lax.dynamic_slice_in_dim(kwp, q0, WINDOW + WIN_Q_BLOCK, axis=2)
        vband = lax.dynamic_slice_in_dim(vwp, q0, WINDOW + WIN_Q_BLOCK, axis=2)
        kpos = q0 - WINDOW + jnp.arange(WINDOW + WIN_Q_BLOCK)
        qpos = q0 + jnp.arange(WIN_Q_BLOCK)
        d = qpos[:, None] - kpos[None, :]
        mask = (kpos[None, :] >= 0) & (d >= 0) & (d < WINDOW)
        s = jnp.einsum('bgrqd,bgkd->bgrqk', qb, kband) * scale
        p = masked_softmax(s, mask)
        return jnp.einsum('bgrqk,bgkd->bgrqd', p.astype(dt), vband)

    o_win = lax.map(win_block, jnp.arange(0, S, WIN_Q_BLOCK))
    o_win = jnp.moveaxis(o_win, 0, 3).reshape(B, G, R, S, D)
    return o_cmp, o_slc, o_win


def hybrid_ab_layer(x, norm_g, w_in, w_out, nsa_q_g, nsa_k_g, pe_k, w1_k, w2_k, pe_v, w1_v, w2_v, cos, sin):
    B, S, _ = x.shape
    h = rms_norm(x, norm_g)
    proj = h @ w_in
    sizes = [RET_WIDTH] * 4 + [NSA_WIDTH] + [NSA_KV_WIDTH] * 6 + [NSA_WIDTH]
    cuts = [int(c) for c in np.cumsum(sizes)]
    (rq, rk, rv, rgate, nq, kc, vc, ks, vs, kw, vw, ngate, ngl) = jnp.split(proj, cuts, axis=-1)
    y_ret = retention(apply_rope(to_heads(rq, RET_HEADS), cos, sin),
                      apply_rope(to_heads(rk, RET_HEADS), cos, sin),
                      to_heads(rv, RET_HEADS))
    y_ret = head_rms(y_ret).transpose(0, 2, 1, 3).reshape(B, S, RET_WIDTH) * jax.nn.silu(rgate)
    q = apply_rope(rms_norm(to_heads(nq, NSA_HEADS), nsa_q_g), cos, sin)
    qg = q.reshape(B, NSA_KV_HEADS, NSA_GROUP, S, HEAD_DIM)
    kv_heads = lambda t: to_heads(t, NSA_KV_HEADS)
    ks_h = apply_rope(rms_norm(kv_heads(ks), nsa_k_g), cos, sin)
    kw_h = apply_rope(rms_norm(kv_heads(kw), nsa_k_g), cos, sin)
    o_cmp, o_slc, o_win = nsa(qg, kv_heads(kc), kv_heads(vc), ks_h, kv_heads(vs), kw_h, kv_heads(vw),
                              nsa_k_g, pe_k, w1_k, w2_k, pe_v, w1_v, w2_v, cos, sin)
    gates = jax.nn.sigmoid(ngl.astype(jnp.float32)).reshape(B, S, 3, NSA_HEADS)
    gates = gates.transpose(2, 0, 3, 1)[..., None].astype(x.dtype)
    hs = (B, NSA_HEADS, S, HEAD_DIM)
    y_nsa = gates[0] * o_cmp.reshape(hs) + gates[1] * o_slc.reshape(hs) + gates[2] * o_win.reshape(hs)
    y_nsa = y_nsa.transpose(0, 2, 1, 3).reshape(B, S, NSA_WIDTH) * jax.nn.silu(ngate)
    y = jnp.concatenate([y_ret, y_nsa], axis=-1)
    return x + y @ w_out


def diff_layer(x, norm_g, w_in, w_out, q_g, k_g, lq1, lk1, lq2, lk2, lambda_init, cos, sin):
    B, S, _ = x.shape
    dt = x.dtype
    scale = HEAD_DIM ** -0.5
    h = rms_norm(x, norm_g)
    proj = h @ w_in
    q, k, v, gate = jnp.split(proj, [DIFF_QK_WIDTH, 2 * DIFF_QK_WIDTH, 2 * DIFF_QK_WIDTH + DIFF_WIDTH], axis=-1)
    q = q.reshape(B, S, DIFF_HEADS, 2, HEAD_DIM).transpose(0, 2, 3, 1, 4)
    k = k.reshape(B, S, DIFF_HEADS, 2, HEAD_DIM).transpose(0, 2, 3, 1, 4)
    q = apply_rope(rms_norm(q, q_g), cos, sin)
    k = apply_rope(rms_norm(k, k_g), cos, sin)
    v = v.reshape(B, S, DIFF_HEADS, DIFF_V_DIM).transpose(0, 2, 1, 3)
    lam = (jnp.exp(jnp.sum(lq1.astype(jnp.float32) * lk1.astype(jnp.float32)))
           - jnp.exp(jnp.sum(lq2.astype(jnp.float32) * lk2.astype(jnp.float32))) + lambda_init)
    kpos = jnp.arange(S)

    def blk(q0):
        qb = lax.dynamic_slice_in_dim(q, q0, ATTN_Q_BLOCK, axis=3)
        s = jnp.einsum('bhcqd,bhckd->bhcqk', qb, k) * scale
        qpos = q0 + jnp.arange(ATTN_Q_BLOCK)
        p = masked_softmax(s, kpos[None, :] <= qpos[:, None])
        a = p[:, :, 0] - lam * p[:, :, 1]
        return jnp.einsum('bhqk,bhkd->bhqd', a.astype(dt), v)

    o = lax.map(blk, jnp.arange(0, S, ATTN_Q_BLOCK))
    o = jnp.moveaxis(o, 0, 2).reshape(B, DIFF_HEADS, S, DIFF_V_DIM)
    o = head_rms(o) * (1.0 - lambda_init)
    o = o.transpose(0, 2, 1, 3).reshape(B, S, DIFF_WIDTH) * jax.nn.silu(gate)
    return x + o @ w_out


def setup_inputs(seed: int = 0) -> dict:
    key = jax.random.key(seed)
    ks = jax.random.split(key, 24)
    f32 = jnp.float32

    def nrm(k, shape, scale):
        return jax.random.normal(k, shape, f32) * scale

    def gain(k, n):
        return 1.0 + 0.02 * jax.random.normal(k, (n,), f32)

    cin = CMP_BLOCK * HEAD_DIM
    return {
        "x": nrm(ks[0], (BATCH, SEQ, D_MODEL), 1.0),
        "l0_norm_g": gain(ks[1], D_MODEL),
        "l0_w_in": nrm(ks[2], (D_MODEL, AB_IN_COLS), D_MODEL ** -0.5),
        "l0_w_out": nrm(ks[3], (AB_OUT_WIDTH, D_MODEL), AB_OUT_WIDTH ** -0.5),
        "l0_nsa_q_norm_g": gain(ks[4], HEAD_DIM),
        "l0_nsa_k_norm_g": gain(ks[5], HEAD_DIM),
        "l0_cmp_pe_k": nrm(ks[6], (CMP_BLOCK, HEAD_DIM), 0.1),
        "l0_cmp_w1_k": nrm(ks[7], (cin, HEAD_DIM), cin ** -0.5),
        "l0_cmp_w2_k": nrm(ks[8], (HEAD_DIM, HEAD_DIM), HEAD_DIM ** -0.5),
        "l0_cmp_pe_v": nrm(ks[9], (CMP_BLOCK, HEAD_DIM), 0.1),
        "l0_cmp_w1_v": nrm(ks[10], (cin, HEAD_DIM), cin ** -0.5),
        "l0_cmp_w2_v": nrm(ks[11], (HEAD_DIM, HEAD_DIM), HEAD_DIM ** -0.5),
        "l1_norm_g": gain(ks[12], D_MODEL),
        "l1_w_in": nrm(ks[13], (D_MODEL, C_IN_COLS), D_MODEL ** -0.5),
        "l1_w_out": nrm(ks[14], (DIFF_WIDTH, D_MODEL), DIFF_WIDTH ** -0.5),
        "l1_q_norm_g": gain(ks[15], HEAD_DIM),
        "l1_k_norm_g": gain(ks[16], HEAD_DIM),
        "l1_lambda_q1": nrm(ks[17], (HEAD_DIM,), 0.1),
        "l1_lambda_k1": nrm(ks[18], (HEAD_DIM,), 0.1),
        "l1_lambda_q2": nrm(ks[19], (HEAD_DIM,), 0.1),
        "l1_lambda_k2": nrm(ks[20], (HEAD_DIM,), 0.1),
    }


def reference(x, l0_norm_g, l0_w_in, l0_w_out, l0_nsa_q_norm_g, l0_nsa_k_norm_g,
              l0_cmp_pe_k, l0_cmp_w1_k, l0_cmp_w2_k, l0_cmp_pe_v, l0_cmp_w1_v, l0_cmp_w2_v,
              l1_norm_g, l1_w_in, l1_w_out, l1_q_norm_g, l1_k_norm_g,
              l1_lambda_q1, l1_lambda_k1, l1_lambda_q2, l1_lambda_k2):
    S = x.shape[1]
    cos, sin = rope_tables(jnp.arange(S))
    layer_params = [
        (l0_norm_g, l0_w_in, l0_w_out, l0_nsa_q_norm_g, l0_nsa_k_norm_g,
         l0_cmp_pe_k, l0_cmp_w1_k, l0_cmp_w2_k, l0_cmp_pe_v, l0_cmp_w1_v, l0_cmp_w2_v),
        (l1_norm_g, l1_w_in, l1_w_out, l1_q_norm_g, l1_k_norm_g,
         l1_lambda_q1, l1_lambda_k1, l1_lambda_q2, l1_lambda_k2),
    ]
    for i in range(DEPTH):
        if i % 2 == 0:
            x = hybrid_ab_layer(x, *layer_params[i], cos, sin)
        else:
            lambda_init = 0.8 - 0.6 * math.exp(-0.3 * i)
            x = diff_layer(x, *layer_params[i], lambda_init, cos, sin)
    return x
```

```cpp
#include <hip/hip_runtime.h>
#include <hip/hip_cooperative_groups.h>
#include <cstdio>
#include <cstdint>
namespace cg = cooperative_groups;

__device__ __forceinline__ int mk_tid(int wv) { int lane; asm volatile("v_mbcnt_lo_u32_b32 %0, -1, 0\n\tv_mbcnt_hi_u32_b32 %0, -1, %0" : "=v"(lane)); return wv * 64 + lane; }

namespace pg8 {
#define PG8_LAS __attribute__((address_space(3)))
typedef unsigned short bf16_t;
typedef short bf16x8 __attribute__((ext_vector_type(8)));
typedef float f32x4 __attribute__((ext_vector_type(4)));
typedef unsigned u32x4 __attribute__((ext_vector_type(4)));
constexpr int BM = 256, BK = 64, HALF = 128, HTB = HALF * BK * 2  , STAGE_BYTES = 8 * HTB, NXCD = 8, WGM = 8;

__host__ __device__ __forceinline__ int lds_byte(int r, int c) { const int st = (r >> 4) * 2 + (c >> 5), rr = r & 15, cc = c & 31, ob = rr * 64 + cc * 2; return st * 1024 + (ob ^ (((ob >> 9) & 1) << 5)); }
__host__ __device__ __forceinline__ void stage_rc(int b, int& R, int& C) { const int st = b / 1024, sb = b % 1024, swz = sb ^ (((sb >> 9) & 1) << 5); R = (st >> 1) * 16 + swz / 64; C = (st & 1) * 32 + (swz % 64) / 2; }
__host__ __device__ __forceinline__ int perm32(int rho) { const int n = rho >> 4, i = rho & 15; return 8 * (i >> 2) + 4 * n + (i & 3); }

struct Unit { int pm, pn; };
struct Gemm { const bf16_t* A; const bf16_t* Bt; int M, N, K; };

struct StaticOrder {
    int nM, nN, nwg, G, c;
    __host__ __device__ __forceinline__ void init(int M, int N, int G_, int c_) { nM = M / BM; nN = N / BM; nwg = nM * nN; G = G_; c = c_; }
    __host__ __device__ __forceinline__ bool next(int i, Unit& u) const {
        const long L = (long)i * G + c; if (L >= nwg) return false;
        int wgid = (int)L; { const int q = nwg / NXCD, r = nwg % NXCD, xcd = wgid % NXCD, off = wgid / NXCD; wgid = (xcd < r ? xcd * (q + 1) : r * (q + 1) + (xcd - r) * q) + off; }
        const int nig = WGM * nN, gid = wgid / nig, fm = gid * WGM, gsz = (nM - fm) < WGM ? (nM - fm) : WGM;
        u.pm = fm + ((wgid % nig) % gsz); u.pn = (wgid % nig) / gsz; return true;
    }
    __device__ __forceinline__ void a_ready(const Unit&) const {}
    __device__ __forceinline__ void done(const Unit&) const {}
};


template <class Epi, class Sched, bool ALIGN_EPI = false, bool SP2 = false>
__device__ __forceinline__ void gemm_phase(PG8_LAS unsigned char* lds, const Gemm g, const Sched& S, const Epi& E, const int wv) {
    int lane; asm volatile("v_mbcnt_lo_u32_b32 %0, -1, 0\n\tv_mbcnt_hi_u32_b32 %0, -1, %0" : "=v"(lane));
    const int wid = wv, tid = wid * 64 + lane, wr = wid >> 2, wc = wid & 3, fr = lane & 15, fq = lane >> 4;
    const int K = g.K, nt = K / BK;
    unsigned voffA[2], voffB[2];
#pragma unroll
    for (int i = 0; i < 2; ++i) { int R, C; stage_rc(tid * 16 + i * 8192, R, C); const int Rb = Epi::PERM ? ((R & ~31) + perm32(R & 31)) : R;
        voffA[i] = (unsigned)(R * K + C) * 2u; voffB[i] = (unsigned)(Rb * K + C) * 2u; }
    const size_t kstep = (size_t)(BK * 2);
    const size_t hstep = (size_t)HALF * K * 2;
    const size_t tstep = 2 * hstep;
    const unsigned ldsw = (unsigned)wid * 1024u;
    const int aoff = lds_byte(wr * 64 + fr, fq * 8), boff = lds_byte(wc * 32 + fr, fq * 8);
#define PG8_SA(b, h) (((b) * 2 + (h)) * HTB)
#define PG8_SB(b, h) ((4 + (b) * 2 + (h)) * HTB)
#define PG8_STAGE(bufoff, gbase, voff) do { _Pragma("unroll") for (int _i = 0; _i < 2; ++_i) \
        __builtin_amdgcn_global_load_lds((const unsigned*)((const char*)(gbase) + (voff)[_i]), (PG8_LAS unsigned*)(lds + (bufoff) + ldsw + _i * 8192), 16, 0, 0); } while (0)
#define PG8_LDA(dst, b, h) do { _Pragma("unroll") for (int m = 0; m < 4; ++m) _Pragma("unroll") for (int k = 0; k < 2; ++k) dst[m][k] = *(const PG8_LAS bf16x8*)(lds + PG8_SA(b, h) + aoff + m * 2048 + k * 1024); } while (0)
#define PG8_LDB(dst, b, h) do { _Pragma("unroll") for (int n = 0; n < 2; ++n) _Pragma("unroll") for (int k = 0; k < 2; ++k) dst[n][k] = *(const PG8_LAS bf16x8*)(lds + PG8_SB(b, h) + boff + n * 2048 + k * 1024); } while (0)
#define PG8_MMA(ai, bj, At, Bt) do { __builtin_amdgcn_s_setprio(1); _Pragma("unroll") for (int m = 0; m < 4; ++m) _Pragma("unroll") for (int n = 0; n < 2; ++n) _Pragma("unroll") for (int k = 0; k < 2; ++k) \
        acc[ai][bj][m][n] = __builtin_amdgcn_mfma_f32_16x16x32_bf16(Bt[n][k], At[m][k], acc[ai][bj][m][n], 0, 0, 0); __builtin_amdgcn_s_setprio(0); } while (0)
#define PG8_WAIT_V(n) asm volatile("s_waitcnt vmcnt(" #n ")" ::: "memory")
#define PG8_WAIT_L(n) asm volatile("s_waitcnt lgkmcnt(" #n ")" ::: "memory")
#define PG8_BAR __builtin_amdgcn_s_barrier()
#define PG8_SCHED __builtin_amdgcn_sched_barrier(0)
    Unit cur, nxt; int ui = 0;
    if (!S.next(0, cur)) return;
    f32x4 acc[2][2][4][2];
#pragma unroll
    for (int a = 0; a < 2; ++a)
#pragma unroll
        for (int b = 0; b < 2; ++b)
#pragma unroll
            for (int m = 0; m < 4; ++m)
#pragma unroll
                for (int n = 0; n < 2; ++n) acc[a][b][m][n] = (f32x4){0.f, 0.f, 0.f, 0.f};
    bf16x8 At[4][2], B0[2][2], B1[2][2];
    const char* cA = (const char*)g.A + (size_t)cur.pm * tstep; const char* cB = (const char*)g.Bt + (size_t)cur.pn * tstep;
    S.a_ready(cur);
    if constexpr (SP2) {
        PG8_STAGE(PG8_SB(0, 0), cB, voffB); PG8_STAGE(PG8_SB(0, 1), cB + hstep, voffB); PG8_STAGE(PG8_SA(0, 0), cA, voffA); PG8_STAGE(PG8_SA(0, 1), cA + hstep, voffA);
        if (wr == 1) PG8_BAR;
        PG8_WAIT_V(2); PG8_BAR;
        PG8_STAGE(PG8_SB(1, 0), cB + kstep, voffB); PG8_STAGE(PG8_SA(1, 0), cA + kstep, voffA); PG8_STAGE(PG8_SB(1, 1), cB + hstep + kstep, voffB);
        PG8_WAIT_V(6); PG8_BAR;
    } else {
        PG8_STAGE(PG8_SB(0, 0), cB, voffB); PG8_STAGE(PG8_SA(0, 0), cA, voffA); PG8_STAGE(PG8_SB(0, 1), cB + hstep, voffB); PG8_STAGE(PG8_SA(0, 1), cA + hstep, voffA);
        if (wr == 1) PG8_BAR;
        PG8_WAIT_V(4); PG8_BAR;
        PG8_STAGE(PG8_SB(1, 0), cB + kstep, voffB); PG8_STAGE(PG8_SA(1, 0), cA + kstep, voffA); PG8_STAGE(PG8_SB(1, 1), cB + hstep + kstep, voffB);
        PG8_WAIT_V(6); PG8_BAR;
    }
    for (;;) {
        const bool has_next = S.next(ui + 1, nxt);
        const char* nA = has_next ? (const char*)g.A + (size_t)nxt.pm * tstep : cA; const char* nB = has_next ? (const char*)g.Bt + (size_t)nxt.pn * tstep : cB;
        for (int t = 0; t < nt; t += 2) {
            const bool last = (t == nt - 2);
            const char* a1 = cA + (size_t)(t + 1) * kstep;
            const char* a2 = last ? nA : cA + (size_t)(t + 2) * kstep; const char* b2 = last ? nB : cB + (size_t)(t + 2) * kstep;
            const char* a3 = a2 + kstep; const char* b3 = b2 + kstep;
            if (last && has_next) S.a_ready(nxt);
            if constexpr (SP2) {
            PG8_LDB(B0, 0, 0); PG8_LDB(B1, 0, 1); PG8_SCHED; PG8_LDA(At, 0, 0); PG8_STAGE(PG8_SA(1, 1), a1 + hstep, voffA);
            PG8_WAIT_V(8); PG8_WAIT_L(0); PG8_BAR; PG8_MMA(0, 0, At, B0); PG8_MMA(0, 1, At, B1); PG8_BAR; PG8_SCHED;
            PG8_LDA(At, 0, 1); PG8_STAGE(PG8_SB(0, 0), b2, voffB); PG8_STAGE(PG8_SB(0, 1), b2 + hstep, voffB); PG8_STAGE(PG8_SA(0, 0), a2, voffA);
            PG8_WAIT_V(8); PG8_WAIT_L(0); PG8_BAR; PG8_MMA(1, 0, At, B0); PG8_MMA(1, 1, At, B1); PG8_BAR; PG8_SCHED;
            PG8_LDB(B0, 1, 0); PG8_LDB(B1, 1, 1); PG8_SCHED; PG8_LDA(At, 1, 0); PG8_STAGE(PG8_SA(0, 1), a2 + hstep, voffA);
            PG8_WAIT_V(8); PG8_WAIT_L(0); PG8_BAR; PG8_MMA(0, 0, At, B0); PG8_MMA(0, 1, At, B1); PG8_BAR; PG8_SCHED;
            PG8_LDA(At, 1, 1); PG8_STAGE(PG8_SB(1, 0), b3, voffB); PG8_STAGE(PG8_SB(1, 1), b3 + hstep, voffB); PG8_STAGE(PG8_SA(1, 0), a3, voffA);
            PG8_WAIT_V(8); PG8_WAIT_L(0); PG8_BAR; PG8_MMA(1, 0, At, B0); PG8_MMA(1, 1, At, B1); PG8_BAR; PG8_SCHED;
            } else {
            PG8_LDB(B0, 0, 0); PG8_SCHED; PG8_LDA(At, 0, 0); PG8_STAGE(PG8_SA(1, 1), a1 + hstep, voffA);
            PG8_WAIT_L(8); PG8_BAR; PG8_WAIT_L(0); PG8_MMA(0, 0, At, B0); PG8_BAR; PG8_SCHED;
            PG8_LDB(B1, 0, 1); PG8_STAGE(PG8_SB(0, 0), b2, voffB);
            PG8_BAR; PG8_WAIT_L(0); PG8_MMA(0, 1, At, B1); PG8_BAR;
            PG8_LDA(At, 0, 1); PG8_STAGE(PG8_SA(0, 0), a2, voffA);
            PG8_BAR; PG8_WAIT_L(0); PG8_MMA(1, 0, At, B0); PG8_BAR; PG8_SCHED;
            PG8_STAGE(PG8_SB(0, 1), b2 + hstep, voffB);
            PG8_WAIT_V(6); PG8_BAR; PG8_MMA(1, 1, At, B1); PG8_BAR;
            PG8_LDB(B0, 1, 0); PG8_SCHED; PG8_LDA(At, 1, 0); PG8_STAGE(PG8_SA(0, 1), a2 + hstep, voffA);
            PG8_WAIT_L(8); PG8_BAR; PG8_WAIT_L(0); PG8_MMA(0, 0, At, B0); PG8_BAR; PG8_SCHED;
            PG8_LDB(B1, 1, 1); PG8_STAGE(PG8_SB(1, 0), b3, voffB);
            PG8_BAR; PG8_WAIT_L(0); PG8_MMA(0, 1, At, B1); PG8_BAR;
            PG8_LDA(At, 1, 1); PG8_STAGE(PG8_SA(1, 0), a3, voffA);
            PG8_BAR; PG8_WAIT_L(0); PG8_MMA(1, 0, At, B0); PG8_BAR; PG8_SCHED;
            PG8_STAGE(PG8_SB(1, 1), b3 + hstep, voffB);
            PG8_WAIT_V(6); PG8_BAR; PG8_MMA(1, 1, At, B1); PG8_BAR;
            }
        }
        if constexpr (ALIGN_EPI) { if (wr == 0) PG8_BAR; }
        if constexpr (!Epi::AFTER_DRAIN) { E(acc, cur, wr, wc, fr, fq, ui); S.done(cur); }
        if (!has_next) break;
#pragma unroll
        for (int a = 0; a < 2; ++a)
#pragma unroll
            for (int b = 0; b < 2; ++b)
#pragma unroll
                for (int m = 0; m < 4; ++m)
#pragma unroll
                    for (int n = 0; n < 2; ++n) acc[a][b][m][n] = (f32x4){0.f, 0.f, 0.f, 0.f};
        cur = nxt; cA = nA; cB = nB; ++ui;
        if constexpr (ALIGN_EPI) { if (wr == 1) PG8_BAR; }
    }
    PG8_WAIT_V(0);
    if constexpr (!ALIGN_EPI) { if (wr == 0) PG8_BAR; }
    PG8_BAR;
    if constexpr (Epi::AFTER_DRAIN) { E.fused(acc, cur, wr, wc, fr, fq, lds, wid, lane); S.done(cur); }
#undef PG8_SA
#undef PG8_SB
#undef PG8_STAGE
#undef PG8_LDA
#undef PG8_LDB
#undef PG8_MMA
#undef PG8_WAIT_V
#undef PG8_WAIT_L
#undef PG8_BAR
#undef PG8_SCHED
}
}

#define LAS __attribute__((address_space(3)))
typedef unsigned short bf16_t;
typedef short bf16x8 __attribute__((ext_vector_type(8)));
typedef short s16x4 __attribute__((ext_vector_type(4)));
typedef float f32x4 __attribute__((ext_vector_type(4)));
typedef float f32x16 __attribute__((ext_vector_type(16)));
typedef unsigned u32x4 __attribute__((ext_vector_type(4)));
typedef unsigned u32x2 __attribute__((ext_vector_type(2)));

constexpr int BATCH = 4, SEQ = 2048, DM = 2048, MTOK = BATCH * SEQ;
constexpr int N0 = 7936, N0REAL = 7704, N1 = 8192;
constexpr float EPS = 1e-6f;
constexpr float LAMBDA_INIT = 0.35550906759096926f;
constexpr float RSQRT_HD = 0.08838834764831845f;

constexpr size_t MiB = (size_t)1 << 20;
constexpr size_t WS_CTL = 0, CTL_BYTES = 24576;
constexpr size_t WS_COS = 1 * MiB, WS_SIN = 1 * MiB + 512 * 1024;
constexpr size_t WS_CW2T = 2 * MiB;
constexpr size_t WS_PB = 2 * MiB + 64 * 1024;
constexpr size_t WS_LAM = 2 * MiB + 96 * 1024;
constexpr size_t WS_KCMP = 2 * MiB + 128 * 1024;
constexpr size_t WS_VCMP = 2 * MiB + 384 * 1024;
constexpr size_t WS_CW1T = 3 * MiB;
constexpr size_t WS_GATES = 5 * MiB;
constexpr size_t WS_RSS1 = 6 * MiB;
constexpr size_t WS_W0OT = 8 * MiB, WS_W1OT = 16 * MiB, WS_W1T = 24 * MiB, WS_W0T = 56 * MiB;
constexpr size_t WS_H0 = 89 * MiB;
constexpr size_t WS_L0 = 121 * MiB;
constexpr size_t WS_RQ = WS_L0, WS_RK = WS_L0 + 16 * MiB, WS_RV = WS_L0 + 32 * MiB, WS_SRG = WS_L0 + 48 * MiB, WS_NQ = WS_L0 + 64 * MiB;
constexpr size_t WS_KC = WS_L0 + 80 * MiB, WS_VC = WS_L0 + 84 * MiB, WS_KS = WS_L0 + 88 * MiB, WS_VS = WS_L0 + 92 * MiB, WS_KW = WS_L0 + 96 * MiB, WS_VW = WS_L0 + 100 * MiB;
constexpr size_t WS_SNG = WS_L0 + 104 * MiB;
constexpr size_t WS_Y0 = 89 * MiB;
constexpr size_t WS_NSCR = 56 * MiB;
constexpr size_t WS_X1B = 121 * MiB;
constexpr size_t WS_Q1 = 56 * MiB, WS_K1 = 89 * MiB, WS_V1 = 153 * MiB, WS_SG1 = 185 * MiB;
constexpr size_t WS_KVS = 241 * MiB;
constexpr size_t WS_OD = 217 * MiB;
constexpr size_t WS_OD1 = 24 * MiB;
constexpr size_t WS_Y1 = WS_OD;
constexpr size_t WS_END = 255 * MiB;

constexpr int LDS_BYTES = 163840;
constexpr int LDS_XT = 131072;
constexpr int LDS_RS = 131072 + 8192;

typedef float f32x2_t __attribute__((ext_vector_type(2))); typedef __bf16 bf16x2_t __attribute__((ext_vector_type(2)));
__device__ __forceinline__ unsigned cvtpk(float lo, float hi) { f32x2_t v = {lo, hi}; bf16x2_t b = __builtin_convertvector(v, bf16x2_t); return __builtin_bit_cast(unsigned, b); }
__device__ __forceinline__ float bf2f(unsigned short b) { return __uint_as_float(((unsigned)b) << 16); }
__device__ __forceinline__ float bflo(unsigned w) { return __uint_as_float(w << 16); }
__device__ __forceinline__ float bfhi(unsigned w) { return __uint_as_float(w & 0xffff0000u); }
__device__ __forceinline__ float silu_f(float x) { return x * __builtin_amdgcn_rcpf(1.0f + __expf(-x)); }
__device__ __forceinline__ float sigmoid_f(float x) { return __builtin_amdgcn_rcpf(1.0f + __expf(-x)); }
__device__ __forceinline__ float wave_sum(float v) {
#pragma unroll
    for (int o = 1; o < 64; o <<= 1) v += __shfl_xor(v, o);
    return v;
}
__host__ __device__ __forceinline__ int l1_block(int pn) { const int xp = pn >> 4, q = (pn >> 2) & 3, k = pn & 3; return ((q & 1) * 2 + (q >> 1)) * 8 + xp * 4 + k; }
__host__ __device__ __forceinline__ int dperm(int lc) { return 16 * (lc >> 5) + 8 * ((lc >> 3) & 1) + 4 * ((lc >> 4) & 1) + (lc & 3) + 64 * ((lc >> 2) & 1); }

struct EpiCommon {
    const float* cosT; const float* sinT; LAS float* xt;
};
__device__ __forceinline__ void st_pair(bf16_t* p, pg8::f32x4 a, pg8::f32x4 b, bool wt) {
    u32x2 w0, w1; w0.x = cvtpk(a[0], a[1]); w0.y = cvtpk(a[2], a[3]); w1.x = cvtpk(b[0], b[1]); w1.y = cvtpk(b[2], b[3]);
    if (wt) {
        __hip_atomic_store((unsigned long long*)p, (unsigned long long)w0.x | ((unsigned long long)w0.y << 32), __ATOMIC_RELAXED, __HIP_MEMORY_SCOPE_AGENT);
        __hip_atomic_store((unsigned long long*)(p + 64), (unsigned long long)w1.x | ((unsigned long long)w1.y << 32), __ATOMIC_RELAXED, __HIP_MEMORY_SCOPE_AGENT);
    } else { *(u32x2*)p = w0; *(u32x2*)(p + 64) = w1; }
}
__device__ __forceinline__ void st_wide(bf16_t* p, pg8::f32x4 a, pg8::f32x4 b) {
    const unsigned a0 = cvtpk(a[0], a[1]), a1 = cvtpk(a[2], a[3]), b0 = cvtpk(b[0], b[1]), b1 = cvtpk(b[2], b[3]);
    const auto rx = __builtin_amdgcn_permlane32_swap(a0, b0, false, false); const auto ry = __builtin_amdgcn_permlane32_swap(a1, b1, false, false);
    u32x4 w; w.x = rx[0]; w.y = ry[0]; w.z = rx[1]; w.w = ry[1];
    *(u32x4*)p = w;
}
enum { T_ROPE = 0, T_RAW = 1, T_SILU = 2, T_NORMROPE = 3, T_NGL = 4 };

__device__ __forceinline__ float xsum_fq(float s) {
    { const auto r = __builtin_amdgcn_permlane16_swap(__float_as_uint(s), __float_as_uint(s), false, false); s = __uint_as_float(r[0]) + __uint_as_float(r[1]); }
    { const auto r = __builtin_amdgcn_permlane32_swap(__float_as_uint(s), __float_as_uint(s), false, false); s = __uint_as_float(r[0]) + __uint_as_float(r[1]); }
    return s;
}
template <bool HAS_RS>
__device__ __forceinline__ void epi_heads(const pg8::f32x4 (&acc)[2][2][4][2], int pm, int wr, int wc, int fr, int fq, int type, bf16_t* dst, size_t sB, size_t sH, size_t sS, int h0,
                                          const float* g, const EpiCommon& C, const LAS float* rsl, float* gates, bool wt = false) {
    const int d0 = 16 * wc + 8 * (fq & 1) + 4 * (fq >> 1);
    const int dst0 = (fq >> 1) ? d0 + 60 : d0;
    if (type == T_NORMROPE) {
#pragma unroll
        for (int ai = 0; ai < 2; ++ai)
#pragma unroll
            for (int m = 0; m < 4; ++m) {
                const int rl = ai * 128 + wr * 64 + m * 16 + fr; const float rs = HAS_RS ? rsl[rl] : 1.0f;
#pragma unroll
                for (int bj = 0; bj < 2; ++bj) {
                    const pg8::f32x4 a = acc[ai][bj][m][0] * rs, b = acc[ai][bj][m][1] * rs;
                    float s = (a[0] * a[0] + a[1] * a[1]) + (a[2] * a[2] + a[3] * a[3]) + (b[0] * b[0] + b[1] * b[1]) + (b[2] * b[2] + b[3] * b[3]);
                    s = xsum_fq(s);
                    if (fq == 0) C.xt[(rl * 2 + bj) * 4 + wc] = s;
                }
            }
        asm volatile("s_waitcnt lgkmcnt(0)" ::: "memory"); __builtin_amdgcn_s_barrier(); asm volatile("" ::: "memory");
    }
    pg8::f32x4 g0 = {1.f, 1.f, 1.f, 1.f}, g1 = {1.f, 1.f, 1.f, 1.f};
    if (type == T_NORMROPE) { g0 = *(const pg8::f32x4*)(g + d0); g1 = *(const pg8::f32x4*)(g + d0 + 64); }
    pg8::f32x4 rf;
#pragma unroll
    for (int j = 0; j < 4; ++j) rf[j] = exp2f(-(float)(d0 + j) * 0.20762050593046014f) * 0.15915494309189535f;
#pragma unroll
    for (int ai = 0; ai < 2; ++ai)
#pragma unroll
        for (int m = 0; m < 4; ++m) {
            const int rl = ai * 128 + wr * 64 + m * 16 + fr, row = pm * 256 + rl, b = row >> 11, s = row & 2047;
            const float rs = HAS_RS ? rsl[rl] : 1.0f;
            pg8::f32x4 cs = {1.f, 1.f, 1.f, 1.f}, sn = {0.f, 0.f, 0.f, 0.f};
            if (type == T_ROPE || type == T_NORMROPE) {
#pragma unroll
                for (int j = 0; j < 4; ++j) { const float rev = __builtin_amdgcn_fractf((float)s * rf[j]); cs[j] = __builtin_amdgcn_cosf(rev); sn[j] = __builtin_amdgcn_sinf(rev); } }
#pragma unroll
            for (int bj = 0; bj < 2; ++bj) {
                pg8::f32x4 a = acc[ai][bj][m][0] * rs, bb = acc[ai][bj][m][1] * rs;
                if (type == T_NGL) {
                    if (bj == 0) {
#pragma unroll
                        for (int j = 0; j < 4; ++j) if (d0 + j < 24) gates[(size_t)row * 24 + d0 + j] = sigmoid_f(a[j]);
                    }
                    continue;
                }
                if (type == T_NORMROPE) {
                    const LAS float* x = C.xt + (rl * 2 + bj) * 4;
                    const float rr = __builtin_amdgcn_rsqf(((x[0] + x[1]) + (x[2] + x[3])) * (1.0f / 128.0f) + EPS);
                    a = a * rr * g0; bb = bb * rr * g1;
                }
                if (type == T_ROPE || type == T_NORMROPE) { const pg8::f32x4 o0 = a * cs - bb * sn, o1 = a * sn + bb * cs; a = o0; bb = o1; }
                if (type == T_SILU) {
#pragma unroll
                    for (int j = 0; j < 4; ++j) { a[j] = silu_f(a[j]); bb[j] = silu_f(bb[j]); }
                }
                if (wt) st_pair(dst + (size_t)b * sB + (size_t)(h0 + bj) * sH + (size_t)s * sS + d0, a, bb, true);
                else st_wide(dst + (size_t)b * sB + (size_t)(h0 + bj) * sH + (size_t)s * sS + dst0, a, bb);
            }
        }
}

#ifndef EPI_WT_ALL
#define EPI_WT_ALL false
#endif
struct EpiL0In {
    static constexpr bool PERM = true, AFTER_DRAIN = false;
    unsigned char* ws; const float* qg; const float* kg; EpiCommon C;
    __device__ __forceinline__ void operator()(const pg8::f32x4 (&acc)[2][2][4][2], const pg8::Unit& u, int wr, int wc, int fr, int fq, int) const {
        const int pn = u.pn; int type; bf16_t* dst; int nh = 8, h0; const float* g = nullptr; bool tokmajor = false;
        if (pn < 4) { type = T_ROPE; dst = (bf16_t*)(ws + WS_RQ); h0 = 2 * pn; }
        else if (pn < 8) { type = T_ROPE; dst = (bf16_t*)(ws + WS_RK); h0 = 2 * (pn - 4); }
        else if (pn < 12) { type = T_RAW; dst = (bf16_t*)(ws + WS_RV); h0 = 2 * (pn - 8); }
        else if (pn < 16) { type = T_SILU; dst = (bf16_t*)(ws + WS_SRG); h0 = 2 * (pn - 12); tokmajor = true; }
        else if (pn < 20) { type = T_NORMROPE; dst = (bf16_t*)(ws + WS_NQ); h0 = 2 * (pn - 16); g = qg; }
        else if (pn < 26) { const int k = pn - 20; nh = 2; h0 = 0; type = (k == 2 || k == 4) ? T_NORMROPE : T_RAW; g = kg;
            dst = (bf16_t*)(ws + (k == 0 ? WS_KC : k == 1 ? WS_VC : k == 2 ? WS_KS : k == 3 ? WS_VS : k == 4 ? WS_KW : WS_VW)); }
        else if (pn < 30) { type = T_SILU; dst = (bf16_t*)(ws + WS_SNG); h0 = 2 * (pn - 26); tokmajor = true; }
        else { type = T_NGL; dst = nullptr; h0 = 0; }
        const size_t sB = tokmajor ? (size_t)SEQ * 1024 : (size_t)nh * SEQ * 128, sH = tokmajor ? 128 : (size_t)SEQ * 128, sS = tokmajor ? 1024 : 128;
        epi_heads<false>(acc, u.pm, wr, wc, fr, fq, type, dst, sB, sH, sS, h0, g, C, nullptr, (float*)(ws + WS_GATES), EPI_WT_ALL || pn == 20 || pn == 21);
        if (pn == 20 || pn == 21) {
            asm volatile("s_waitcnt vmcnt(0)" ::: "memory");
            __builtin_amdgcn_s_barrier(); asm volatile("" ::: "memory");
            if (wr == 0 && wc == 0 && fr == 0 && fq == 0)
                __hip_atomic_fetch_add((unsigned*)(ws + WS_CTL) + 256, 1u, __ATOMIC_RELAXED, __HIP_MEMORY_SCOPE_AGENT);
        }
    }
};
struct EpiL1In {
    static constexpr bool PERM = true, AFTER_DRAIN = false;
    unsigned char* ws; const float* qg; const float* kg; EpiCommon C; const LAS float* rsl; int skip;
    __device__ __forceinline__ void operator()(const pg8::f32x4 (&acc)[2][2][4][2], const pg8::Unit& u, int wr, int wc, int fr, int fq, int ui) const {
        if (skip) { if (acc[0][0][0][0][0] == 12345.678f) *(float*)(ws + WS_CTL + 4096) = 1.f; return; }
        const int pn = l1_block(u.pn); int type; bf16_t* dst; int h0; const float* g = nullptr; bool tokmajor = false;
        if (pn < 8) { type = T_NORMROPE; dst = (bf16_t*)(ws + WS_Q1); h0 = 2 * pn; g = qg; }
        else if (pn < 16) { type = T_NORMROPE; dst = (bf16_t*)(ws + WS_K1); h0 = 2 * (pn - 8); g = kg; }
        else if (pn < 24) { type = T_RAW; dst = (bf16_t*)(ws + WS_V1); h0 = 2 * (pn - 16); }
        else { type = T_SILU; dst = (bf16_t*)(ws + WS_SG1); h0 = 2 * (pn - 24); tokmajor = true; }
        const size_t sB = tokmajor ? (size_t)SEQ * 2048 : (size_t)16 * SEQ * 128, sH = tokmajor ? 128 : (size_t)SEQ * 128, sS = tokmajor ? 2048 : 128;
        epi_heads<true>(acc, u.pm, wr, wc, fr, fq, type, dst, sB, sH, sS, h0, g, C, rsl + ui * 256, nullptr, EPI_WT_ALL);
    }
};
struct EpiL0Out {
    static constexpr bool PERM = true, AFTER_DRAIN = false;
    const float* x; bf16_t* x1b; float* rss;
    __device__ __forceinline__ void operator()(const pg8::f32x4 (&acc)[2][2][4][2], const pg8::Unit& u, int wr, int wc, int fr, int fq, int) const {
#pragma unroll
        for (int ai = 0; ai < 2; ++ai) {
            pg8::f32x4 res[4][2][2];
#pragma unroll
            for (int m = 0; m < 4; ++m) { const int row = u.pm * 256 + ai * 128 + wr * 64 + m * 16 + fr;
#pragma unroll
                for (int bj = 0; bj < 2; ++bj) { const size_t off = (size_t)row * DM + u.pn * 256 + bj * 128 + wc * 32 + 8 * fq;
                    res[m][bj][0] = __builtin_nontemporal_load((const pg8::f32x4*)(x + off)); res[m][bj][1] = __builtin_nontemporal_load((const pg8::f32x4*)(x + off + 4)); } }
#pragma unroll
            for (int m = 0; m < 4; ++m) {
                const int row = u.pm * 256 + ai * 128 + wr * 64 + m * 16 + fr; float ss = 0.f;
#pragma unroll
                for (int bj = 0; bj < 2; ++bj) {
                    const size_t off = (size_t)row * DM + u.pn * 256 + bj * 128 + wc * 32 + 8 * fq;
                    const pg8::f32x4 a = acc[ai][bj][m][0] + res[m][bj][0], b = acc[ai][bj][m][1] + res[m][bj][1];
                    u32x4 w; w.x = cvtpk(a[0], a[1]); w.y = cvtpk(a[2], a[3]); w.z = cvtpk(b[0], b[1]); w.w = cvtpk(b[2], b[3]);
                    *(u32x4*)(x1b + off) = w;
                    ss += (a[0] * a[0] + a[1] * a[1]) + (a[2] * a[2] + a[3] * a[3]) + (b[0] * b[0] + b[1] * b[1]) + (b[2] * b[2] + b[3] * b[3]);
                }
                ss = xsum_fq(ss);
                if (fq == 0) rss[(size_t)row * 32 + u.pn * 4 + wc] = ss;
            }
        }
    }
};
struct EpiL1Out {
    static constexpr bool PERM = true, AFTER_DRAIN = false;
    float* out; const bf16_t* x1b;
    __device__ __forceinline__ void operator()(const pg8::f32x4 (&acc)[2][2][4][2], const pg8::Unit& u, int wr, int wc, int fr, int fq, int) const {
        u32x4 res[2][4][2];
#pragma unroll
        for (int ai = 0; ai < 2; ++ai)
#pragma unroll
            for (int m = 0; m < 4; ++m) { const int row = u.pm * 256 + ai * 128 + wr * 64 + m * 16 + fr;
#pragma unroll
                for (int bj = 0; bj < 2; ++bj) res[ai][m][bj] = __builtin_nontemporal_load((const u32x4*)(x1b + (size_t)row * DM + u.pn * 256 + bj * 128 + wc * 32 + 8 * fq)); }
#pragma unroll
        for (int ai = 0; ai < 2; ++ai)
#pragma unroll
            for (int m = 0; m < 4; ++m) {
                const int row = u.pm * 256 + ai * 128 + wr * 64 + m * 16 + fr;
#pragma unroll
                for (int bj = 0; bj < 2; ++bj) {
                    const size_t off = (size_t)row * DM + u.pn * 256 + bj * 128 + wc * 32 + 8 * fq;
                    const u32x4 w = res[ai][m][bj];
                    const pg8::f32x4 r0 = {bflo(w.x), bfhi(w.x), bflo(w.y), bfhi(w.y)}, r1 = {bflo(w.z), bfhi(w.z), bflo(w.w), bfhi(w.w)};
                    *(pg8::f32x4*)(out + off) = acc[ai][bj][m][0] + r0; *(pg8::f32x4*)(out + off + 4) = acc[ai][bj][m][1] + r1;
                }
            }
    }
};

__device__ __forceinline__ unsigned f2bf(float f) { unsigned u = __float_as_uint(f); return (u + 0x7fffu + ((u >> 16) & 1u)) >> 16; }
__device__ __forceinline__ unsigned pk2(float lo, float hi) { return f2bf(lo) | (f2bf(hi) << 16); }
struct PrepIn { const float *x, *g0, *w0in, *w0out, *pek, *w1k, *w2k, *pev, *w1v, *w2v, *g1, *w1in, *w1out, *lq1, *lk1, *lq2, *lk2; };
struct TItem { const float* W; bf16_t* WT; const float* gk; int K, Nw, kb, nb, mode, cs; f32x4 gka, gkb; };
constexpr int I_W0 = 32 * (N0 / 32), I_WO = 32 * 64, I_W1 = 32 * (N1 / 32), I_C1 = 64 * 4, I_C2 = 2 * 4;
constexpr int NITEMS_T = I_W0 + 2 * I_WO + I_W1 + 2 * I_C1 + 2 * I_C2;
__device__ __forceinline__ TItem t_decode(const PrepIn& I, unsigned char* ws, int it) {
    TItem t; t.gk = nullptr; t.mode = 0; t.cs = 0; int r = it;
    if (r < I_W0) { t.W = I.w0in; t.WT = (bf16_t*)(ws + WS_W0T); t.K = DM; t.Nw = N0REAL; t.kb = r / (N0 / 32); t.nb = r % (N0 / 32); t.mode = 1; t.cs = 1; return t; } r -= I_W0;
    if (r < I_WO) { t.W = I.w0out; t.WT = (bf16_t*)(ws + WS_W0OT); t.K = DM; t.Nw = DM; t.kb = r / 64; t.nb = r % 64; return t; } r -= I_WO;
    if (r < I_W1) { t.W = I.w1in; t.WT = (bf16_t*)(ws + WS_W1T); t.K = DM; t.Nw = N1; t.kb = r / (N1 / 32); t.nb = r % (N1 / 32); t.mode = 2; t.gk = I.g1; return t; } r -= I_W1;
    if (r < I_WO) { t.W = I.w1out; t.WT = (bf16_t*)(ws + WS_W1OT); t.K = DM; t.Nw = DM; t.kb = r / 64; t.nb = r % 64; return t; } r -= I_WO;
    if (r < I_C1) { t.W = I.w1k; t.WT = (bf16_t*)(ws + WS_CW1T); t.K = 4096; t.Nw = 128; t.kb = r / 4; t.nb = r % 4; t.cs = 2; return t; } r -= I_C1;
    if (r < I_C1) { t.W = I.w1v; t.WT = (bf16_t*)(ws + WS_CW1T) + 128 * 4096; t.K = 4096; t.Nw = 128; t.kb = r / 4; t.nb = r % 4; t.cs = 2; return t; } r -= I_C1;
    if (r < I_C2) { t.W = I.w2k; t.WT = (bf16_t*)(ws + WS_CW2T); t.K = 128; t.Nw = 128; t.kb = r / 4; t.nb = r % 4; return t; } r -= I_C2;
    t.W = I.w2v; t.WT = (bf16_t*)(ws + WS_CW2T) + 128 * 128; t.K = 128; t.Nw = 128; t.kb = r / 4; t.nb = r % 4; return t;
}
__device__ __forceinline__ void t_load(TItem& t, int lane, float (&v)[32]) {
    if (t.gk) { const f32x4* gp = (const f32x4*)(t.gk + 64 * t.kb + 8 * (lane & 7)); t.gka = gp[0]; t.gkb = gp[1]; }
    const int np = 32 * t.nb + 4 * (lane & 7);
    const int src = t.mode == 2 ? (l1_block(np >> 8) * 256 + (np & 128) + dperm(np & 127)) : t.mode ? ((np & ~127) + dperm(np & 127)) : np; const bool valid = src < t.Nw;
    const float* p = t.W + (size_t)(64 * t.kb + (lane >> 3)) * t.Nw + (valid ? src : 0);
#pragma unroll
    for (int i = 0; i < 8; ++i) { const f32x4 w = __builtin_nontemporal_load((const f32x4*)(p + (size_t)(8 * i) * t.Nw)); v[4 * i] = w[0]; v[4 * i + 1] = w[1]; v[4 * i + 2] = w[2]; v[4 * i + 3] = w[3]; }
}
__device__ __forceinline__ void t_store(const TItem& t, int lane, const float (&v)[32], LAS float* scr, unsigned char* wsb) {
    const int k0 = 64 * t.kb, n0 = 32 * t.nb, np = n0 + 4 * (lane & 7);
    const int src = t.mode == 2 ? (l1_block(np >> 8) * 256 + (np & 128) + dperm(np & 127)) : t.mode ? ((np & ~127) + dperm(np & 127)) : np; const bool valid = src < t.Nw;
    float sc = valid ? 1.0f : 0.0f; if (t.cs == 1 && src >= 1024 && src < 2048) sc = RSQRT_HD;
#pragma unroll
    for (int i = 0; i < 8; ++i) { const int kk = 8 * i + (lane >> 3);
#pragma unroll
        for (int j = 0; j < 4; ++j) scr[kk * 33 + 4 * (lane & 7) + j] = v[4 * i + j] * sc; }
    asm volatile("s_waitcnt lgkmcnt(0)" ::: "memory");
    const int c = lane & 7;
#pragma unroll
    for (int j = 0; j < 4; ++j) { const int n = (lane >> 3) + 8 * j; const LAS float* s = scr + (8 * c) * 33 + n;
        float e0 = s[0 * 33], e1 = s[1 * 33], e2 = s[2 * 33], e3 = s[3 * 33], e4 = s[4 * 33], e5 = s[5 * 33], e6 = s[6 * 33], e7 = s[7 * 33];
        if (t.gk) { e0 *= t.gka[0]; e1 *= t.gka[1]; e2 *= t.gka[2]; e3 *= t.gka[3]; e4 *= t.gkb[0]; e5 *= t.gkb[1]; e6 *= t.gkb[2]; e7 *= t.gkb[3]; }
        u32x4 o; o.x = pk2(e0, e1); o.y = pk2(e2, e3); o.z = pk2(e4, e5); o.w = pk2(e6, e7);
        const size_t off = (t.cs == 2) ? ((size_t)((((k0 + 8 * c) >> 4) * 4 + ((n0 + n) >> 5)) * 64 + (((k0 + 8 * c) >> 3) & 1) * 32 + ((n0 + n) & 31)) * 8) : ((size_t)(n0 + n) * t.K + k0 + 8 * c);
        { const __amdgpu_buffer_rsrc_t r_ = __builtin_amdgcn_make_buffer_rsrc((void*)wsb, 0, 0x7fffffff, 0x00020000);
          __builtin_amdgcn_raw_buffer_store_b128(o, r_, (int)((const unsigned char*)(t.WT + off) - wsb), 0, 16); } }
    asm volatile("s_waitcnt lgkmcnt(0)" ::: "memory");
}
__device__ __forceinline__ void p0_prep(const PrepIn& I, unsigned char* ws, LAS unsigned char* lds, int gw, int NGW, int wave, int lane) {
    LAS float* scr = (LAS float*)(lds + wave * 16384);
    {
        constexpr int NP0 = I_W0 + 2 * I_C1 + 2 * I_C2, SKIP = 2 * I_WO + I_W1;
#define P0IDX(i) ((i) < I_W0 ? (i) : (i) + SKIP)
        float va[32], vb[32], vc[32], vd[32]; TItem ta, tb, tc, td;
        const int i0 = gw, i1 = gw + NGW, i2 = gw + 2 * NGW, i3 = gw + 3 * NGW, i4 = gw + 4 * NGW;
        if (i0 < NP0) { ta = t_decode(I, ws, P0IDX(i0)); t_load(ta, lane, va); }
        if (i1 < NP0) { tb = t_decode(I, ws, P0IDX(i1)); t_load(tb, lane, vb); }
        if (i2 < NP0) { tc = t_decode(I, ws, P0IDX(i2)); t_load(tc, lane, vc); }
        if (i3 < NP0) { td = t_decode(I, ws, P0IDX(i3)); t_load(td, lane, vd); }
        if (i0 < NP0) t_store(ta, lane, va, scr, ws);
        if (i4 < NP0) { ta = t_decode(I, ws, P0IDX(i4)); t_load(ta, lane, va); }
        if (i1 < NP0) t_store(tb, lane, vb, scr, ws);
        if (i2 < NP0) t_store(tc, lane, vc, scr, ws);
        if (i3 < NP0) t_store(td, lane, vd, scr, ws);
        if (i4 < NP0) t_store(ta, lane, va, scr, ws);
        for (int it = i4 + NGW; it < NP0; it += NGW) { ta = t_decode(I, ws, P0IDX(it)); t_load(ta, lane, va); t_store(ta, lane, va, scr, ws); }
#undef P0IDX
    }
    {
        const f32x4* gr = (const f32x4*)I.g0 + lane; f32x4 g[8];
#pragma unroll
        for (int j = 0; j < 8; ++j) g[j] = gr[64 * j];
        for (int m0 = gw; m0 < MTOK; m0 += 4 * NGW) {
            f32x4 v[4][8];
#pragma unroll
            for (int q = 0; q < 4; ++q) { const int m = m0 + q * NGW; if (m < MTOK) { const f32x4* xr = (const f32x4*)(I.x + (size_t)m * DM) + lane;
#pragma unroll
                for (int j = 0; j < 8; ++j) v[q][j] = __builtin_nontemporal_load(&xr[64 * j]); } }
#pragma unroll
            for (int q = 0; q < 4; ++q) { const int m = m0 + q * NGW; if (m < MTOK) { float s = 0.f;
#pragma unroll
                for (int j = 0; j < 8; ++j) s += (v[q][j][0] * v[q][j][0] + v[q][j][1] * v[q][j][1]) + (v[q][j][2] * v[q][j][2] + v[q][j][3] * v[q][j][3]);
                const float r = 1.0f / sqrtf(wave_sum(s) * (1.0f / DM) + EPS);
                u32x2* o = (u32x2*)((bf16_t*)(ws + WS_H0) + (size_t)m * DM) + lane;
#pragma unroll
                for (int j = 0; j < 8; ++j) { u32x2 w; w.x = cvtpk(v[q][j][0] * r * g[j][0], v[q][j][1] * r * g[j][1]); w.y = cvtpk(v[q][j][2] * r * g[j][2], v[q][j][3] * r * g[j][3]); o[64 * j] = w; } } }
        }
    }
    for (int e = gw * 64 + lane; e < SEQ * 64; e += NGW * 64) {
        const int pos = e >> 6, i = e & 63;
        const float inv = 1.0f / powf(10000.0f, (float)(2 * i) / 128.0f);
        const float angf = (float)pos * inv;
        const double a = (double)angf, k = rint(a * 0.15915494309189535), r = a - k * 6.283185307179586476925;
        const double r2 = r * r; double cs = 1.0, sn = r, tc = 1.0, ts = r;
#pragma unroll
        for (int n = 1; n <= 15; ++n) { tc *= -r2 / (double)((2 * n - 1) * (2 * n)); ts *= -r2 / (double)((2 * n) * (2 * n + 1)); cs += tc; sn += ts; }
        ((float*)(ws + WS_COS))[e] = (float)cs; ((float*)(ws + WS_SIN))[e] = (float)sn;
    }
    if (gw == NGW - 1) {
        const float a = wave_sum(I.lq1[lane] * I.lk1[lane] + I.lq1[lane + 64] * I.lk1[lane + 64]);
        const float b = wave_sum(I.lq2[lane] * I.lk2[lane] + I.lq2[lane + 64] * I.lk2[lane + 64]);
        if (lane == 0) *(float*)(ws + WS_LAM) = expf(a) - expf(b) + LAMBDA_INIT;
    }
}

constexpr int NCONV = (2 * I_WO + I_W1) / 64;
__device__ __forceinline__ void conv_item(const PrepIn& I, unsigned char* ws, LAS unsigned char* lds, int c, const int wv) {
    const int lane = mk_tid(wv) & 63;
    LAS float* scr = (LAS float*)(lds + wv * 16384);
    const int base = I_W0 + c * 64 + wv * 8;
    float va[32], vb[32], vc[32], vd[32]; TItem ta, tb, tc, td;
    ta = t_decode(I, ws, base); t_load(ta, lane, va); tb = t_decode(I, ws, base + 1); t_load(tb, lane, vb);
    tc = t_decode(I, ws, base + 2); t_load(tc, lane, vc); td = t_decode(I, ws, base + 3); t_load(td, lane, vd);
    t_store(ta, lane, va, scr, ws); ta = t_decode(I, ws, base + 4); t_load(ta, lane, va);
    t_store(tb, lane, vb, scr, ws); tb = t_decode(I, ws, base + 5); t_load(tb, lane, vb);
    t_store(tc, lane, vc, scr, ws); tc = t_decode(I, ws, base + 6); t_load(tc, lane, vc);
    t_store(td, lane, vd, scr, ws); td = t_decode(I, ws, base + 7); t_load(td, lane, vd);
    t_store(ta, lane, va, scr, ws); t_store(tb, lane, vb, scr, ws); t_store(tc, lane, vc, scr, ws); t_store(td, lane, vd, scr, ws);
}

namespace att {
constexpr int NW = 8, QBLK = 32, KVBLK = 64, D = 128;
constexpr int SHM_V = KVBLK * D * 2, SHM_K = KVBLK * D * 2;
constexpr int LDS_WS = 2 * SHM_V + 2 * SHM_K;
constexpr int LDS_IMP = LDS_WS + NW * 64 * 4;
constexpr int LDS_SC = LDS_IMP + 8 * 32 * 33 * 4;
constexpr int LDS_SELM = LDS_SC + 64 * 33 * 4;
constexpr float SCALE = 0.08838834764831845f, C2 = 1.4426950408889634f * SCALE, THR = 8.f;
#define KSWZ(row, colB) ((row) * 256 + ((colB) ^ (((row) & 7) << 4)))
#define SBAR() __builtin_amdgcn_sched_barrier(0)
__device__ __forceinline__ int v_st(int k, int c) { const int kk = (k & ~0xC) | ((k & 4) << 1) | ((k & 8) >> 1); return ((kk >> 3) * 4 + (c >> 5)) * 512 + ((kk & 7) * 32 + (c & 31)) * 2; }
__device__ __forceinline__ int v_rd_base(int lane) { return ((lane & 3) << 3) | (((lane >> 2) & 3) << 6) | (((lane >> 4) & 1) << 5) | (((lane >> 5) & 1) << 8); }
constexpr int v_rd_off(int d0, int ks, int half) { return d0 * 512 + ks * 4096 + half * 2048; }
__device__ __forceinline__ int crow(int r, int hi) { return (r & 3) + 8 * (r >> 2) + 4 * hi; }
__device__ __forceinline__ void mask_tile(f32x16& p0, f32x16& p1, int dq, unsigned W) {
    const float NEG = -__builtin_inff();
#pragma unroll
    for (int r = 0; r < 16; ++r) {
        const int c = (r & 3) + 8 * (r >> 2);
        if ((unsigned)(dq - c) >= W) p0[r] = NEG;
        if ((unsigned)(dq - c - 32) >= W) p1[r] = NEG;
    }
}
__device__ __forceinline__ void mask_all(f32x16& p0, f32x16& p1, bool keep) {
    const float NEG = -__builtin_inff();
#pragma unroll
    for (int r = 0; r < 16; ++r) { p0[r] = keep ? p0[r] : NEG; p1[r] = keep ? p1[r] : NEG; }
}
__device__ __forceinline__ void partialSM(f32x16& p0, f32x16& p1, float& m_reg, float& mn, float& alpha) {
    float pmax = p0[0];
#pragma unroll
    for (int r = 1; r < 16; ++r) pmax = fmaxf(pmax, p0[r]);
#pragma unroll
    for (int r = 0; r < 16; ++r) pmax = fmaxf(pmax, p1[r]);
    { auto rr = __builtin_amdgcn_permlane32_swap(__float_as_uint(pmax), __float_as_uint(pmax), false, false);
      pmax = fmaxf(__uint_as_float(rr[0]), __uint_as_float(rr[1])); }
    if (__builtin_expect(__all((pmax - m_reg) * SCALE <= THR), 1)) { mn = m_reg; alpha = 1.f; }
    else { mn = fmaxf(m_reg, pmax); alpha = __builtin_amdgcn_exp2f((m_reg - mn) * C2); m_reg = mn; }
    const float mnL = -mn * C2;
#pragma unroll
    for (int r = 0; r < 16; ++r) p0[r] = fmaf(p0[r], C2, mnL);
#pragma unroll
    for (int r = 0; r < 16; ++r) p1[r] = fmaf(p1[r], C2, mnL);
#pragma unroll
    for (int r = 0; r < 16; ++r) p0[r] = __builtin_amdgcn_exp2f(p0[r]);
}
#define PK4(P, B_, OUT) do { unsigned a0 = cvtpk(P[B_+0], P[B_+1]), a1 = cvtpk(P[B_+2], P[B_+3]);                          \
        unsigned b0 = cvtpk(P[B_+4], P[B_+5]), b1 = cvtpk(P[B_+6], P[B_+7]);                                             \
        auto r0 = __builtin_amdgcn_permlane32_swap(a0, b0, false, false); auto r1 = __builtin_amdgcn_permlane32_swap(a1, b1, false, false); \
        u32x4 w = {r0[0], r1[0], r0[1], r1[1]}; OUT = *reinterpret_cast<bf16x8*>(&w); } while (0)
__device__ __forceinline__ void pack_p(const f32x16& p0, const f32x16& p1, bf16x8& pa0, bf16x8& pa1, bf16x8& pa2, bf16x8& pa3) {
    PK4(p0, 0, pa0); PK4(p0, 8, pa1); PK4(p1, 0, pa2); PK4(p1, 8, pa3);
}
__device__ __forceinline__ void finishSM(f32x16& p0, f32x16& p1, float alpha, float& l_reg, bf16x8& pa0, bf16x8& pa1, bf16x8& pa2, bf16x8& pa3) {
#pragma unroll
    for (int r = 0; r < 16; ++r) p1[r] = __builtin_amdgcn_exp2f(p1[r]);
    float ps = 0;
#pragma unroll
    for (int r = 0; r < 16; ++r) ps += p0[r];
#pragma unroll
    for (int r = 0; r < 16; ++r) ps += p1[r];
    { auto rr = __builtin_amdgcn_permlane32_swap(__float_as_uint(ps), __float_as_uint(ps), false, false);
      ps = __uint_as_float(rr[0]) + __uint_as_float(rr[1]); }
    l_reg = l_reg * alpha + ps;
    pack_p(p0, p1, pa0, pa1, pa2, pa3);
}
__device__ __forceinline__ void decay_apply(f32x16& p0, f32x16& p1, int dq, float lg) {
#pragma unroll
    for (int r = 0; r < 16; ++r) {
        const int c = (r & 3) + 8 * (r >> 2); const int e0 = dq - c, e1 = dq - c - 32;
        const float w0 = __builtin_amdgcn_exp2f((float)e0 * lg), w1 = __builtin_amdgcn_exp2f((float)e1 * lg);
        p0[r] = e0 >= 0 ? p0[r] * w0 : 0.f; p1[r] = e1 >= 0 ? p1[r] * w1 : 0.f;
    }
}
__device__ __forceinline__ void decay_fast(f32x16& p0, f32x16& p1, int dq, float lg, const float (&dc)[16]) {
    const float a0 = __builtin_amdgcn_exp2f((float)dq * lg), a1 = a0 * __builtin_amdgcn_exp2f(-32.0f * lg);
#pragma unroll
    for (int r = 0; r < 16; ++r) { p0[r] *= a0 * dc[r]; p1[r] *= a1 * dc[r]; }
}
template <int KB>
__device__ __forceinline__ void qkt(f32x16& p0, f32x16& p1, const char* K_lds, int r32, int hi, const bf16x8* qr) {
    p0 = f32x16{}; p1 = f32x16{};
    const char* kb[4];
#pragma unroll
    for (int dd = 0; dd < 4; ++dd) kb[dd] = K_lds + KB * SHM_K + KSWZ(r32, (dd * 16 + hi * 8) * 2);
#pragma unroll
    for (int d0 = 0; d0 < 8; ++d0) { const char* a = kb[d0 & 3] + (d0 >> 2) * 128;
        bf16x8 b0 = *reinterpret_cast<const bf16x8*>(a);
        bf16x8 b1 = *reinterpret_cast<const bf16x8*>(a + 32 * 256);
        p0 = __builtin_amdgcn_mfma_f32_32x32x16_bf16(b0, qr[d0], p0, 0, 0, 0);
        p1 = __builtin_amdgcn_mfma_f32_32x32x16_bf16(b1, qr[d0], p1, 0, 0, 0); }
}
template <int VB>
__device__ __forceinline__ void pv_tile(f32x16* o, int vb0, bf16x8 pa0, bf16x8 pa1, bf16x8 pa2, bf16x8 pa3) {
#define TRRD(dst, off) asm volatile("ds_read_b64_tr_b16 %0, %1 offset:%2" : "=&v"(dst) : "v"(vb0), "i"(off) : "memory")
#define PV_D0(d0) do { s16x4 l0, l1, l2, l3, h0, h1, h2, h3; constexpr int b_ = VB * SHM_V + v_rd_off(d0, 0, 0); \
        TRRD(l0, b_); TRRD(h0, b_ + 2048); TRRD(l1, b_ + 4096); TRRD(h1, b_ + 6144); TRRD(l2, b_ + 8192); TRRD(h2, b_ + 10240); TRRD(l3, b_ + 12288); TRRD(h3, b_ + 14336); \
        asm volatile("s_waitcnt lgkmcnt(0)" ::: "memory"); SBAR();   \
        o[d0] = __builtin_amdgcn_mfma_f32_32x32x16_bf16(pa0, (bf16x8){l0[0], l0[1], l0[2], l0[3], h0[0], h0[1], h0[2], h0[3]}, o[d0], 0, 0, 0);   \
        o[d0] = __builtin_amdgcn_mfma_f32_32x32x16_bf16(pa1, (bf16x8){l1[0], l1[1], l1[2], l1[3], h1[0], h1[1], h1[2], h1[3]}, o[d0], 0, 0, 0);   \
        o[d0] = __builtin_amdgcn_mfma_f32_32x32x16_bf16(pa2, (bf16x8){l2[0], l2[1], l2[2], l2[3], h2[0], h2[1], h2[2], h2[3]}, o[d0], 0, 0, 0);   \
        o[d0] = __builtin_amdgcn_mfma_f32_32x32x16_bf16(pa3, (bf16x8){l3[0], l3[1], l3[2], l3[3], h3[0], h3[1], h3[2], h3[3]}, o[d0], 0, 0, 0); } while (0)
    PV_D0(0); PV_D0(1); PV_D0(2); PV_D0(3);
#undef PV_D0
#undef TRRD
}
#define VMW() asm volatile("s_waitcnt vmcnt(0)" ::: "memory")

template <int MODE>
__device__ __forceinline__ void attn_core(f32x16 (&o)[4], float& l_reg, const bf16x8 (&qr)[8], const bf16_t* __restrict__ Kh, const bf16_t* __restrict__ Vh,
                                          int j_lo, int NT, int qlo, int W, unsigned selm, bool use_sel, float lg, char* lds, const int wv) {
    const int tid = mk_tid(wv);
    const int wid = wv, lane = tid & 63, r32 = lane & 31, hi = lane >> 5;
    char* V_lds = lds; char* K_lds = lds + 2 * SHM_V;
    float* ws = (float*)(lds + LDS_WS) + wid * 64; float* al_l = ws + 32;
    float m_reg = -1e30f; l_reg = 0.f;
#pragma unroll
    for (int d = 0; d < 4; ++d) o[d] = f32x16{};
    const int vb0 = (int)(uintptr_t)V_lds + v_rd_base(lane);
    const int qm = qlo + r32 - 4 * hi;
    LAS unsigned char* lds3 = (LAS unsigned char*)lds;
    int koff[2], voff[2];
#pragma unroll
    for (int i = 0; i < 2; ++i) { const int ob = i * 8192 + wid * 1024 + lane * 16;
        const int row = ob >> 8, ch = ((ob >> 4) & 15) ^ (row & 7); koff[i] = row * D + ch * 8;
        const int st = ob >> 9, kk = (st >> 2) * 8 + ((ob & 511) >> 6), cc = (st & 3) * 32 + ((ob & 63) >> 1);
        const int key = (kk & ~0xC) | ((kk & 4) << 1) | ((kk & 8) >> 1); voff[i] = key * D + cc; }
    const unsigned ldsw = (unsigned)wid * 1024u;
#define KBASE(t) ((j_lo + (t)) * KVBLK)
#define GLDS(src, dstoff) __builtin_amdgcn_global_load_lds((const unsigned*)(src), (LAS unsigned*)(lds3 + (dstoff)), 16, 0, 0)
#define DMA_K(t, bf) do { _Pragma("unroll") for (int i_ = 0; i_ < 2; ++i_) GLDS(Kh + (size_t)KBASE(t) * D + koff[i_], 2 * SHM_V + (bf) * SHM_K + i_ * 8192 + ldsw); } while (0)
#define DMA_V(t, bf) do { _Pragma("unroll") for (int i_ = 0; i_ < 2; ++i_) GLDS(Vh + (size_t)KBASE(t) * D + voff[i_], (bf) * SHM_V + i_ * 8192 + ldsw); } while (0)
#define RESC(a) do { if (MODE != 2) { if (__any((a) < 1.f)) { if (hi == 0) al_l[r32] = (a); asm volatile("s_waitcnt lgkmcnt(0)" ::: "memory");              \
                     for (int d_ = 0; d_ < 4; ++d_) for (int r = 0; r < 16; ++r) o[d_][r] *= al_l[crow(r, hi)]; } } } while (0)
#define MASKT(P0_, P1_, t) do { const int kb_ = KBASE(t); \
        if (MODE == 0) { if (kb_ + KVBLK - 1 > qlo || kb_ <= qlo + QBLK - 1 - W) mask_tile(P0_, P1_, qm - kb_, (unsigned)W); } \
        if (MODE == 1) { if (kb_ + KVBLK - 1 > qlo) mask_tile(P0_, P1_, qm - kb_, 0x40000000u); if (use_sel) mask_all(P0_, P1_, ((selm >> (j_lo + (t))) & 1u) != 0u); } } while (0)
#define PART(P0_, P1_, mnX, alX, t) do { if (MODE == 2) { if (KBASE(t) + KVBLK - 1 <= qlo) decay_fast(P0_, P1_, qm - KBASE(t), lg, dc); else decay_apply(P0_, P1_, qm - KBASE(t), lg); alX = 1.f; } else partialSM(P0_, P1_, m_reg, mnX, alX); } while (0)
#define FINI(P0_, P1_, alY) do { if (MODE == 2) pack_p(P0_, P1_, pa0, pa1, pa2, pa3); else finishSM(P0_, P1_, alY, l_reg, pa0, pa1, pa2, pa3); } while (0)
    f32x16 pA0, pA1, pB0, pB1; float mnA = 0.f, mnB = 0.f, alA = 1.f, alB = 1.f; bf16x8 pa0, pa1, pa2, pa3;
    float dc[16];
    if (MODE == 2) {
#pragma unroll
        for (int r = 0; r < 16; ++r) dc[r] = __builtin_amdgcn_exp2f(-(float)((r & 3) + 8 * (r >> 2)) * lg); }
    __syncthreads();
    DMA_K(0, 0);
    VMW(); __syncthreads();
    if (NT > 1) DMA_K(1, 1);
    DMA_V(0, 0);
    SBAR(); qkt<0>(pA0, pA1, K_lds, r32, hi, qr);
    MASKT(pA0, pA1, 0); PART(pA0, pA1, mnA, alA, 0);
    VMW(); __syncthreads();
#define STEP(PX0, PX1, mnX, alX, PY0, PY1, alY, t, KB, VB) do {                                                      \
        if ((t) + 1 < NT) DMA_K((t) + 1, VB);                                                                        \
        DMA_V((t), KB);                                                                                              \
        SBAR(); qkt<KB>(PX0, PX1, K_lds, r32, hi, qr);                                                               \
        FINI(PY0, PY1, alY); SBAR();                                                                                 \
        pv_tile<VB>(o, vb0, pa0, pa1, pa2, pa3); MASKT(PX0, PX1, (t)); PART(PX0, PX1, mnX, alX, (t));               \
        RESC(alX);                                                                                                   \
        VMW(); __syncthreads(); } while (0)
    for (int t = 1; t + 1 < NT; t += 2) {
        STEP(pB0, pB1, mnB, alB, pA0, pA1, alA, t, 1, 0);
        STEP(pA0, pA1, mnA, alA, pB0, pB1, alB, t + 1, 0, 1);
    }
    const bool even = (NT & 1) == 0;
    if (even) { DMA_V(NT - 1, 1); SBAR(); qkt<1>(pB0, pB1, K_lds, r32, hi, qr); SBAR(); }
    FINI(pA0, pA1, alA); SBAR();
    pv_tile<0>(o, vb0, pa0, pa1, pa2, pa3);
    if (even) { MASKT(pB0, pB1, NT - 1); PART(pB0, pB1, mnB, alB, NT - 1); RESC(alB);
        VMW(); __syncthreads();
        FINI(pB0, pB1, alB); SBAR(); pv_tile<1>(o, vb0, pa0, pa1, pa2, pa3); }
#undef STEP
#undef FINI
#undef PART
#undef MASKT
#undef RESC
#undef DMA_V
#undef DMA_K
#undef GLDS
#undef KBASE
}
__device__ __forceinline__ void bcast_rows(float v, float* li_l, int r32, int hi, float (&rs)[16]) {
    if (hi == 0) li_l[r32] = v;
    asm volatile("s_waitcnt lgkmcnt(0)" ::: "memory");
#pragma unroll
    for (int r = 0; r < 16; ++r) rs[r] = li_l[crow(r, hi)];
    asm volatile("s_waitcnt lgkmcnt(0)" ::: "memory");
}
__device__ __forceinline__ void load_q(bf16x8 (&qr)[8], const bf16_t* Qw, int r32, int hi) {
#pragma unroll
    for (int d0 = 0; d0 < 8; ++d0) qr[d0] = *(const bf16x8*)(Qw + (size_t)r32 * D + d0 * 16 + hi * 8);
}
__device__ __forceinline__ void rowsum32(float (&s)[16]) {
#pragma unroll
    for (int off = 1; off < 32; off <<= 1)
#pragma unroll
        for (int r = 0; r < 16; ++r) s[r] += __shfl_xor(s[r], off);
}
}

__device__ __forceinline__ void compress_item(unsigned char* ws, const float* kg, const float* pek, const float* pev, char* lds, int item, const int wv) {
    const int tid = mk_tid(wv);
    const int wid = wv, lane = tid & 63, r32 = lane & 31, hi = lane >> 5;
    const int p = item >> 2, rg = item & 3;
    const int kv = p >> 3, bg = p & 7;
    const bf16_t* T = (const bf16_t*)(ws + (kv ? WS_VC : WS_KC)) + (size_t)bg * SEQ * 128;
    const bf16_t* W1T = (const bf16_t*)(ws + WS_CW1T) + (size_t)kv * 128 * 4096;
    const bf16_t* W2T = (const bf16_t*)(ws + WS_CW2T) + (size_t)kv * 128 * 128;
    float* red = (float*)lds;
    bf16_t* hid = (bf16_t*)(lds + 131072);
    f32x16 acc[4];
#pragma unroll
    for (int c = 0; c < 4; ++c) acc[c] = f32x16{};
    const int kbase = 512 * wid + 8 * hi;
    const bf16_t* ab = T + (size_t)(16 * (32 * rg + r32)) * 128 + kbase;
    const bf16_t* bb = W1T + (size_t)(wid * 32 * 4) * 512 + (size_t)lane * 8;
    const float* pe = (kv ? pev : pek) + kbase;
#pragma unroll 2
    for (int kh = 0; kh < 8; ++kh) {
        bf16x8 a[4], b[4][4];
#pragma unroll
        for (int ks = 0; ks < 4; ++ks) { a[ks] = *(const bf16x8*)(ab + 16 * (4 * kh + ks));
            { const f32x4 e0 = *(const f32x4*)(pe + 16 * (4 * kh + ks)), e1 = *(const f32x4*)(pe + 16 * (4 * kh + ks) + 4);
              const u32x4 w = *reinterpret_cast<const u32x4*>(&a[ks]); u32x4 o;
              o.x = cvtpk(bflo(w.x) + e0[0], bfhi(w.x) + e0[1]); o.y = cvtpk(bflo(w.y) + e0[2], bfhi(w.y) + e0[3]); o.z = cvtpk(bflo(w.z) + e1[0], bfhi(w.z) + e1[1]); o.w = cvtpk(bflo(w.w) + e1[2], bfhi(w.w) + e1[3]);
              a[ks] = *reinterpret_cast<const bf16x8*>(&o); }
#pragma unroll
            for (int cb = 0; cb < 4; ++cb) b[ks][cb] = *(const bf16x8*)(bb + (size_t)((4 * kh + ks) * 4 + cb) * 512); }
#pragma unroll
        for (int ks = 0; ks < 4; ++ks)
#pragma unroll
            for (int cb = 0; cb < 4; ++cb) acc[cb] = __builtin_amdgcn_mfma_f32_32x32x16_bf16(a[ks], b[ks][cb], acc[cb], 0, 0, 0);
    }
    __syncthreads();
#pragma unroll
    for (int cb = 0; cb < 4; ++cb)
#pragma unroll
        for (int r = 0; r < 16; ++r) red[(wid * 32 + att::crow(r, hi)) * 128 + cb * 32 + r32] = acc[cb][r];
    __syncthreads();
    {
        const int col = tid & 127;
#pragma unroll
        for (int i = 0; i < 8; ++i) { const int e = tid + 512 * i, row = e >> 7; float s = 0.f;
#pragma unroll
            for (int w = 0; w < 8; ++w) s += red[(w * 32 + row) * 128 + col];
            hid[row * 128 + col] = (bf16_t)f2bf(silu_f(s)); }
    }
    __syncthreads();
    if (wid < 4) {
        f32x16 a2 = f32x16{};
#pragma unroll
        for (int ks = 0; ks < 8; ++ks) { const bf16x8 a = *(const bf16x8*)(hid + r32 * 128 + 16 * ks + 8 * hi); const bf16x8 b = *(const bf16x8*)(W2T + (size_t)(wid * 32 + r32) * 128 + 16 * ks + 8 * hi);
            a2 = __builtin_amdgcn_mfma_f32_32x32x16_bf16(a, b, a2, 0, 0, 0); }
#pragma unroll
        for (int r = 0; r < 16; ++r) red[att::crow(r, hi) * 128 + wid * 32 + r32] = a2[r];
    }
    __syncthreads();
    bf16_t* OUT = (bf16_t*)(ws + (kv ? WS_VCMP : WS_KCMP)) + (size_t)bg * 128 * 128;
#pragma unroll
    for (int e = 0; e < 4; ++e) {
        const int row = wid + 8 * e, n = 32 * rg + row; float x1 = red[row * 128 + lane], x2 = red[row * 128 + 64 + lane];
        if (kv == 0) {
            const float rr = 1.0f / sqrtf(wave_sum(x1 * x1 + x2 * x2) * (1.0f / 128.0f) + EPS);
            const int pos = (n < 127) ? 16 * n + 31 : 0;
            const float y1 = x1 * rr * kg[lane], y2 = x2 * rr * kg[lane + 64];
            const float c = ((const float*)(ws + WS_COS))[pos * 64 + lane], s = ((const float*)(ws + WS_SIN))[pos * 64 + lane];
            x1 = y1 * c - y2 * s; x2 = y1 * s + y2 * c;
        }
        if (n >= 127) { x1 = 0.f; x2 = 0.f; }
        OUT[(size_t)n * 128 + lane] = (bf16_t)f2bf(x1); OUT[(size_t)n * 128 + 64 + lane] = (bf16_t)f2bf(x2);
    }
    __syncthreads();
}

__device__ __forceinline__ void stage_o(char* lds, int wid, const f32x16 (&o)[4], const float (&rs)[16], int r32, int hi) {
    bf16_t* stg = (bf16_t*)lds + wid * 4096;
    asm volatile("" : "+v"(r32), "+v"(hi));
#pragma unroll
    for (int r = 0; r < 16; ++r) { const int orow = att::crow(r, hi);
#pragma unroll
        for (int d0 = 0; d0 < 4; ++d0) { const float v = o[d0][r] * rs[r]; stg[orow * 128 + d0 * 32 + r32] = (bf16_t)(cvtpk(v, v) & 0xffffu); } }
    asm volatile("s_waitcnt lgkmcnt(0)" ::: "memory");
}
__device__ __forceinline__ u32x4 ldo(const char* lds, int wid, int i, int lane) { return *(const u32x4*)((const bf16_t*)lds + wid * 4096 + (i * 4 + (lane >> 4)) * 128 + (lane & 15) * 8); }
__device__ __forceinline__ void unpack8(const u32x4 w, float (&f)[8]) { f[0] = bflo(w.x); f[1] = bfhi(w.x); f[2] = bflo(w.y); f[3] = bfhi(w.y); f[4] = bflo(w.z); f[5] = bfhi(w.z); f[6] = bflo(w.w); f[7] = bfhi(w.w); }
__device__ __forceinline__ u32x4 pack8f(const float (&f)[8]) { u32x4 w; w.x = cvtpk(f[0], f[1]); w.y = cvtpk(f[2], f[3]); w.z = cvtpk(f[4], f[5]); w.w = cvtpk(f[6], f[7]); return w; }
__device__ __forceinline__ void copy_staged(const char* lds, int wid, int lane, bf16_t* dst, size_t stride) {
    asm volatile("" : "+v"(lane));
#pragma unroll
    for (int i = 0; i < 8; ++i) { const u32x4 w = ldo(lds, wid, i, lane); *(u32x4*)(dst + (size_t)(i * 4 + (lane >> 4)) * stride + (lane & 15) * 8) = w; }
}
__device__ __forceinline__ void st16_wt(unsigned char* wsb, const void* p, u32x4 v) {
    const __amdgpu_buffer_rsrc_t r = __builtin_amdgcn_make_buffer_rsrc((void*)wsb, 0, 0x7fffffff, 0x00020000);
    __builtin_amdgcn_raw_buffer_store_b128(v, r, (int)((const unsigned char*)p - wsb), 0, 16);
}
__device__ __forceinline__ void copy_staged_wt(const char* lds, int wid, int lane, __amdgpu_buffer_rsrc_t rsrc, unsigned base_bytes, unsigned stride_bytes) {
    asm volatile("" : "+v"(lane));
#pragma unroll
    for (int i = 0; i < 8; ++i) { const u32x4 w = ldo(lds, wid, i, lane);
        __builtin_amdgcn_raw_buffer_store_b128(w, rsrc, (int)(base_bytes + (unsigned)(i * 4 + (lane >> 4)) * stride_bytes + (unsigned)(lane & 15) * 16u), 0, 16); }
}
__device__ __forceinline__ void nsa_unit(unsigned char* ws, char* lds, int bg, int tb, int part, const int wv) {
    using namespace att;
    const int tid = mk_tid(wv);
    const int wid = wv, lane = tid & 63, r32 = lane & 31, hi = lane >> 5;
    const int b = bg >> 1, g = bg & 1, P0 = tb * 64, rh = wid >> 1, half = wid & 1, hq = g * 4 + rh;
    const int qlo = P0 + 32 * half, tok = qlo + r32;
    float* wsf = (float*)(lds + LDS_WS) + wid * 64;
    bf16_t* SA = (bf16_t*)(ws + WS_NSCR) + (size_t)(bg * 32 + tb) * 65536;
    bf16_t* SB = SA + 32768;
    bf16x8 qr[8];
    load_q(qr, (const bf16_t*)(ws + WS_NQ) + ((size_t)(b * 8 + hq) * SEQ + qlo) * 128, r32, hi);
    const float* gates0 = (const float*)(ws + WS_GATES) + ((size_t)b * SEQ + qlo) * 24 + hq;
#define GATE(br) ({ int l_ = r32; asm volatile("" : "+v"(l_)); gates0[l_ * 24 + 8 * (br)]; })
    f32x16 o[4]; float rs[16];
    if (part != 2) {
        const bf16_t* Kc = (const bf16_t*)(ws + WS_KCMP) + (size_t)bg * 128 * 128; const bf16_t* Vc = (const bf16_t*)(ws + WS_VCMP) + (size_t)bg * 128 * 128;
        char* V_lds = lds; char* K_lds = lds + 2 * SHM_V;
        const int sr = tid >> 4, sc = (tid & 15) * 8, vst0 = v_st(sr, sc), vst1 = v_st(32 + sr, sc), kws = KSWZ(sr, sc * 2);
        const int vb0 = (int)(uintptr_t)V_lds + v_rd_base(lane);
        __syncthreads();
#pragma unroll
        for (int t = 0; t < 2; ++t) {
            const bf16x8 v0 = *(const bf16x8*)(Vc + (size_t)(64 * t + sr) * 128 + sc), v1 = *(const bf16x8*)(Vc + (size_t)(64 * t + 32 + sr) * 128 + sc);
            const bf16x8 k0 = *(const bf16x8*)(Kc + (size_t)(64 * t + sr) * 128 + sc), k1 = *(const bf16x8*)(Kc + (size_t)(64 * t + 32 + sr) * 128 + sc);
            *(bf16x8*)(V_lds + t * SHM_V + vst0) = v0; *(bf16x8*)(V_lds + t * SHM_V + vst1) = v1;
            *(bf16x8*)(K_lds + t * SHM_K + kws) = k0; *(bf16x8*)(K_lds + t * SHM_K + kws + 32 * 256) = k1;
        }
        __syncthreads();
        f32x16 pA0, pA1, pB0, pB1;
        qkt<0>(pA0, pA1, K_lds, r32, hi, qr); qkt<1>(pB0, pB1, K_lds, r32, hi, qr);
        int nvalid = (tok - 15) >> 4; nvalid = nvalid < 0 ? 0 : nvalid;
        const float NEG = -__builtin_inff();
        float mx = NEG;
#pragma unroll
        for (int r = 0; r < 16; ++r) { const int n = (r & 3) + 8 * (r >> 2) + 4 * hi;
            pA0[r] = (n < nvalid) ? pA0[r] : NEG; pA1[r] = (n + 32 < nvalid) ? pA1[r] : NEG; pB0[r] = (n + 64 < nvalid) ? pB0[r] : NEG; pB1[r] = (n + 96 < nvalid) ? pB1[r] : NEG;
            mx = fmaxf(fmaxf(mx, pA0[r]), fmaxf(pA1[r], fmaxf(pB0[r], pB1[r]))); }
        { auto rr = __builtin_amdgcn_permlane32_swap(__float_as_uint(mx), __float_as_uint(mx), false, false); mx = fmaxf(__uint_as_float(rr[0]), __uint_as_float(rr[1])); }
        const float mL = (mx == NEG) ? 0.f : -mx * C2; float ps = 0.f;
#pragma unroll
        for (int r = 0; r < 16; ++r) { pA0[r] = __builtin_amdgcn_exp2f(fmaf(pA0[r], C2, mL)); pA1[r] = __builtin_amdgcn_exp2f(fmaf(pA1[r], C2, mL));
            pB0[r] = __builtin_amdgcn_exp2f(fmaf(pB0[r], C2, mL)); pB1[r] = __builtin_amdgcn_exp2f(fmaf(pB1[r], C2, mL)); ps += (pA0[r] + pA1[r]) + (pB0[r] + pB1[r]); }
        { auto rr = __builtin_amdgcn_permlane32_swap(__float_as_uint(ps), __float_as_uint(ps), false, false); ps = __uint_as_float(rr[0]) + __uint_as_float(rr[1]); }
        const float inv = ps > 0.f ? 1.0f / ps : 0.f;
#pragma unroll
        for (int r = 0; r < 16; ++r) { pA0[r] *= inv; pA1[r] *= inv; pB0[r] *= inv; pB1[r] *= inv; }
        if (tb >= 16) {
            float* IMP = (float*)(lds + LDS_IMP) + (wid * 32 + r32) * 33;
#define IMPQ(P, q) do { _Pragma("unroll") for (int k = 0; k < 4; ++k) { \
                const float gs = (P[4 * k] + P[4 * k + 1]) + (P[4 * k + 2] + P[4 * k + 3]); const float last = P[4 * k + 3]; \
                auto rr = __builtin_amdgcn_permlane32_swap(__float_as_uint(last), __float_as_uint(last), false, false); \
                const float lp = hi ? __uint_as_float(rr[0]) : __uint_as_float(rr[1]);       \
                gsum[q * 4 + k] = gs; lpar[q * 4 + k] = lp; } } while (0)
            float gsum[16], lpar[16];
            IMPQ(pA0, 0); IMPQ(pA1, 1); IMPQ(pB0, 2); IMPQ(pB1, 3);
#undef IMPQ
#pragma unroll
            for (int i = 0; i < 16; ++i) {
                const float prev = hi ? lpar[i] : (i > 0 ? lpar[i - 1] : 0.f);
                IMP[2 * i + hi] = gsum[i] + prev;
            }
        }
        bf16x8 pa0, pa1, pa2, pa3;
#pragma unroll
        for (int d = 0; d < 4; ++d) o[d] = f32x16{};
        pack_p(pA0, pA1, pa0, pa1, pa2, pa3); SBAR(); pv_tile<0>(o, vb0, pa0, pa1, pa2, pa3);
        pack_p(pB0, pB1, pa0, pa1, pa2, pa3); SBAR(); pv_tile<1>(o, vb0, pa0, pa1, pa2, pa3);
        bcast_rows(GATE(0), wsf, r32, hi, rs);
        __syncthreads();
        stage_o(lds, wid, o, rs, r32, hi);
        copy_staged(lds, wid, lane, SA + (size_t)(wid * 32) * 128, 128);
        __syncthreads();
        if (tb >= 16) {
            float* IMPb = (float*)(lds + LDS_IMP); float* SC = (float*)(lds + LDS_SC); unsigned* SELM = (unsigned*)(lds + LDS_SELM);
#pragma unroll
            for (int e = 0; e < 4; ++e) { const int idx = tid + 512 * e, tk = idx >> 5, m = idx & 31;
                float s = 0.f;
#pragma unroll
                for (int r = 0; r < 4; ++r) s += IMPb[((2 * r + (tk >> 5)) * 32 + (tk & 31)) * 33 + m];
                const bool forced = (m == 0) || (m == tb) || (m == tb - 1);
                SC[tk * 33 + m] = forced ? 1e9f : (m <= tb ? s : -1e9f); }
            __syncthreads();
#pragma unroll
            for (int e = 0; e < 4; ++e) { const int idx = tid + 512 * e, tk = idx >> 5, m = idx & 31;
                const float v = SC[tk * 33 + m]; int rank = 0;
                for (int j = 0; j < 32; ++j) { const float u = SC[tk * 33 + j]; rank += (u > v || (u == v && j < m)) ? 1 : 0; }
                const unsigned long long bal = __ballot(rank < 16 && m <= tb);
                if ((lane & 31) == 0) SELM[tk] = hi ? (unsigned)(bal >> 32) : (unsigned)bal; }
            __syncthreads();
        }
    }
    if (part != 2) {
        const unsigned selm = (tb >= 16) ? ((const unsigned*)(lds + LDS_SELM))[32 * half + r32] : 0xffffffffu;
        float l_reg;
        attn_core<1>(o, l_reg, qr, (const bf16_t*)(ws + WS_KS) + (size_t)bg * SEQ * 128, (const bf16_t*)(ws + WS_VS) + (size_t)bg * SEQ * 128, 0, tb + 1, qlo, 0, selm, tb >= 16, 0.f, lds, wv);
        const int lane = mk_tid(wv) & 63, r32 = lane & 31, hi = lane >> 5;
        bcast_rows(GATE(1) / l_reg, wsf, r32, hi, rs);
        __syncthreads();
        stage_o(lds, wid, o, rs, r32, hi);
        if (part == 0) copy_staged(lds, wid, lane, SB + (size_t)(wid * 32) * 128, 128);
        else {
            asm volatile("s_waitcnt vmcnt(0)" ::: "memory");
            const __amdgpu_buffer_rsrc_t sar = __builtin_amdgcn_make_buffer_rsrc((void*)SA, 0, 65536, 0x00020000);
            int ln = lane; asm volatile("" : "+v"(ln));
#pragma unroll
            for (int i = 0; i < 8; ++i) { const int row = i * 4 + (ln >> 4), c = (ln & 15) * 8;
                float w[8], a[8]; unpack8(ldo(lds, wid, i, ln), w); unpack8(*(const u32x4*)(SA + (size_t)(wid * 32 + row) * 128 + c), a);
#pragma unroll
                for (int j = 0; j < 8; ++j) w[j] += a[j];
                __builtin_amdgcn_raw_buffer_store_b128(pack8f(w), sar, (int)(((wid * 32 + row) * 128 + c) * 2), 0, 16); }
        }
    }
    const bf16_t* sng = (const bf16_t*)(ws + WS_SNG) + ((size_t)b * SEQ + qlo) * 1024 + hq * 128;
    bf16_t* y = (bf16_t*)(ws + WS_Y0) + ((size_t)b * SEQ + qlo) * DM + 1024 + hq * 128;
    if (part != 1) {
        const int lowk = P0 - 511, j_lo = lowk > 0 ? lowk / 64 : 0;
        float l_reg;
        attn_core<0>(o, l_reg, qr, (const bf16_t*)(ws + WS_KW) + (size_t)bg * SEQ * 128, (const bf16_t*)(ws + WS_VW) + (size_t)bg * SEQ * 128, j_lo, tb + 1 - j_lo, qlo, 512, 0u, false, 0.f, lds, wv);
        const int lane = mk_tid(wv) & 63, r32 = lane & 31, hi = lane >> 5;
        bcast_rows(GATE(2) / l_reg, wsf, r32, hi, rs);
        __syncthreads();
        stage_o(lds, wid, o, rs, r32, hi);
        if (part == 0) {
            asm volatile("s_waitcnt vmcnt(0)" ::: "memory");
            int ln = lane; asm volatile("" : "+v"(ln));
#pragma unroll
            for (int i = 0; i < 8; ++i) { const int row = i * 4 + (ln >> 4), c = (ln & 15) * 8;
                float w[8], a[8], bq[8], gt[8];
                unpack8(ldo(lds, wid, i, ln), w); unpack8(*(const u32x4*)(SA + (size_t)(wid * 32 + row) * 128 + c), a); unpack8(*(const u32x4*)(SB + (size_t)(wid * 32 + row) * 128 + c), bq);
                unpack8(*(const u32x4*)(sng + (size_t)row * 1024 + c), gt);
#pragma unroll
                for (int j = 0; j < 8; ++j) w[j] = (w[j] + a[j] + bq[j]) * gt[j];
                st16_wt(ws, y + (size_t)row * DM + c, pack8f(w)); }
        } else {
            const __amdgpu_buffer_rsrc_t sbr = __builtin_amdgcn_make_buffer_rsrc((void*)SB, 0, 65536, 0x00020000);
            copy_staged_wt(lds, wid, lane, sbr, (unsigned)(wid * 32 * 128 * 2), 256u);
        }
    }
    if (part != 0) {
        unsigned* flag = (unsigned*)(lds + LDS_BYTES - 32);
        asm volatile("s_waitcnt vmcnt(0)" ::: "memory");
        __syncthreads();
        if (mk_tid(wv) == 0) {
            unsigned* cnt = (unsigned*)(ws + WS_CTL) + 768 + (bg * 32 + tb);
            const unsigned old = __hip_atomic_fetch_add(cnt, 1u, __ATOMIC_RELAXED, __HIP_MEMORY_SCOPE_AGENT);
            if (old == 1u) { __builtin_amdgcn_fence(__ATOMIC_ACQUIRE, "agent"); asm volatile("s_waitcnt vmcnt(0)" ::: "memory"); }
            *flag = old;
        }
        __syncthreads();
        if (*flag == 1u) {
            int ln = mk_tid(wv) & 63;
#pragma unroll
            for (int i = 0; i < 8; ++i) { const int row = i * 4 + (ln >> 4), c = (ln & 15) * 8;
                float a[8], bq[8], gt[8];
                unpack8(*(const u32x4*)(SA + (size_t)(wid * 32 + row) * 128 + c), a); unpack8(*(const u32x4*)(SB + (size_t)(wid * 32 + row) * 128 + c), bq);
                unpack8(*(const u32x4*)(sng + (size_t)row * 1024 + c), gt);
#pragma unroll
                for (int j = 0; j < 8; ++j) a[j] = (a[j] + bq[j]) * gt[j];
                st16_wt(ws, y + (size_t)row * DM + c, pack8f(a)); }
        }
    }
}
#undef GATE
__device__ __forceinline__ void kv_unit(unsigned char* ws, char* lds, int bh, int m, float lg, const int wv) {
    using namespace att;
    const int tid = mk_tid(wv);
    const int wid = wv, lane = tid & 63, r32 = lane & 31, hi = lane >> 5;
    const bf16_t* Kh = (const bf16_t*)(ws + WS_RK) + ((size_t)bh * SEQ + 256 * m) * 128; const bf16_t* Vh = (const bf16_t*)(ws + WS_RV) + ((size_t)bh * SEQ + 256 * m) * 128;
    const int sr = tid >> 4, sc = (tid & 15) * 8, vst0 = v_st(sr, sc), vst1 = v_st(32 + sr, sc);
    const int db = wid & 3, ep = wid >> 2;
    const int vbA = (int)(uintptr_t)lds + v_rd_base(lane) + db * 512, vbB = (int)(uintptr_t)lds + SHM_V + v_rd_base(lane) + ep * 1024;
    f32x16 acc0 = f32x16{}, acc1 = f32x16{};
#pragma unroll 1
    for (int t = 0; t < 4; ++t) {
        const bf16x8 v0 = *(const bf16x8*)(Vh + (size_t)(64 * t + sr) * 128 + sc), v1 = *(const bf16x8*)(Vh + (size_t)(64 * t + 32 + sr) * 128 + sc);
        const u32x4 k0 = *(const u32x4*)(Kh + (size_t)(64 * t + sr) * 128 + sc), k1 = *(const u32x4*)(Kh + (size_t)(64 * t + 32 + sr) * 128 + sc);
        const float w0 = __builtin_amdgcn_exp2f((float)(256 - (64 * t + sr)) * lg), w1 = __builtin_amdgcn_exp2f((float)(256 - (64 * t + 32 + sr)) * lg);
        u32x4 a, b2;
        a.x = cvtpk(bflo(k0.x) * w0, bfhi(k0.x) * w0); a.y = cvtpk(bflo(k0.y) * w0, bfhi(k0.y) * w0); a.z = cvtpk(bflo(k0.z) * w0, bfhi(k0.z) * w0); a.w = cvtpk(bflo(k0.w) * w0, bfhi(k0.w) * w0);
        b2.x = cvtpk(bflo(k1.x) * w1, bfhi(k1.x) * w1); b2.y = cvtpk(bflo(k1.y) * w1, bfhi(k1.y) * w1); b2.z = cvtpk(bflo(k1.z) * w1, bfhi(k1.z) * w1); b2.w = cvtpk(bflo(k1.w) * w1, bfhi(k1.w) * w1);
        __syncthreads();
        *(u32x4*)(lds + vst0) = a; *(u32x4*)(lds + vst1) = b2;
        *(bf16x8*)(lds + SHM_V + vst0) = v0; *(bf16x8*)(lds + SHM_V + vst1) = v1;
        __syncthreads();
#define TRRD(dst, base, off) asm volatile("ds_read_b64_tr_b16 %0, %1 offset:%2" : "=&v"(dst) : "v"(base), "i"(off) : "memory")
#pragma unroll
        for (int ks = 0; ks < 4; ++ks) { s16x4 al, ah, b0l, b0h, b1l, b1h;
            if (ks == 0) { TRRD(al, vbA, 0); TRRD(ah, vbA, 2048); TRRD(b0l, vbB, 0); TRRD(b0h, vbB, 2048); TRRD(b1l, vbB, 512); TRRD(b1h, vbB, 512 + 2048); }
            if (ks == 1) { TRRD(al, vbA, 4096); TRRD(ah, vbA, 4096 + 2048); TRRD(b0l, vbB, 4096); TRRD(b0h, vbB, 4096 + 2048); TRRD(b1l, vbB, 4096 + 512); TRRD(b1h, vbB, 4096 + 512 + 2048); }
            if (ks == 2) { TRRD(al, vbA, 8192); TRRD(ah, vbA, 8192 + 2048); TRRD(b0l, vbB, 8192); TRRD(b0h, vbB, 8192 + 2048); TRRD(b1l, vbB, 8192 + 512); TRRD(b1h, vbB, 8192 + 512 + 2048); }
            if (ks == 3) { TRRD(al, vbA, 12288); TRRD(ah, vbA, 12288 + 2048); TRRD(b0l, vbB, 12288); TRRD(b0h, vbB, 12288 + 2048); TRRD(b1l, vbB, 12288 + 512); TRRD(b1h, vbB, 12288 + 512 + 2048); }
            asm volatile("s_waitcnt lgkmcnt(0)" ::: "memory"); SBAR();
            const bf16x8 af = (bf16x8){al[0], al[1], al[2], al[3], ah[0], ah[1], ah[2], ah[3]};
            acc0 = __builtin_amdgcn_mfma_f32_32x32x16_bf16(af, (bf16x8){b0l[0], b0l[1], b0l[2], b0l[3], b0h[0], b0h[1], b0h[2], b0h[3]}, acc0, 0, 0, 0);
            acc1 = __builtin_amdgcn_mfma_f32_32x32x16_bf16(af, (bf16x8){b1l[0], b1l[1], b1l[2], b1l[3], b1h[0], b1h[1], b1h[2], b1h[3]}, acc1, 0, 0, 0); }
#undef TRRD
    }
    float* KV = (float*)(ws + WS_KVS) + (size_t)(bh * 7 + m) * 16384;
#pragma unroll
    for (int r = 0; r < 16; ++r) { const int d = 32 * db + crow(r, hi);
        __hip_atomic_store(KV + d * 128 + 32 * (2 * ep) + r32, acc0[r], __ATOMIC_RELAXED, __HIP_MEMORY_SCOPE_AGENT);
        __hip_atomic_store(KV + d * 128 + 32 * (2 * ep + 1) + r32, acc1[r], __ATOMIC_RELAXED, __HIP_MEMORY_SCOPE_AGENT); }
    asm volatile("s_waitcnt vmcnt(0)" ::: "memory");
    __syncthreads();
    if (tid == 0) __hip_atomic_fetch_add((unsigned*)(ws + WS_CTL) + 320 + bh, 1u, __ATOMIC_RELAXED, __HIP_MEMORY_SCOPE_AGENT);
}
__device__ __forceinline__ void ret_unit(unsigned char* ws, char* lds, int bh, int qb, float lg, const int wv) {
    using namespace att;
    const int wid = wv;
    const int b = bh >> 3, h = bh & 7, qlo = qb * 256 + wid * 32;
    bf16x8 qr[8];
    { const int lane = mk_tid(wv) & 63; load_q(qr, (const bf16_t*)(ws + WS_RQ) + ((size_t)bh * SEQ + qlo) * 128, lane & 31, lane >> 5); }
    f32x16 o[4]; float l_reg;
    if (qb > 0 && mk_tid(wv) == 0) { const unsigned* ck = (const unsigned*)(ws + WS_CTL) + 320 + bh; unsigned sp_ = 0;
        while (__hip_atomic_load(ck, __ATOMIC_RELAXED, __HIP_MEMORY_SCOPE_AGENT) < 7u) { __builtin_amdgcn_s_sleep(4); if (++sp_ > (1u << 22)) break; }
        __builtin_amdgcn_fence(__ATOMIC_ACQUIRE, "agent"); }
    attn_core<2>(o, l_reg, qr, (const bf16_t*)(ws + WS_RK) + (size_t)bh * SEQ * 128, (const bf16_t*)(ws + WS_RV) + (size_t)bh * SEQ * 128, 4 * qb, 4, qlo, 0, 0u, false, lg, lds, wv);
    const int tid = mk_tid(wv);
    const int lane = tid & 63, r32 = lane & 31, hi = lane >> 5;
    if (qb > 0) {
        __syncthreads();
        {
            const int sr = tid >> 4, sc = (tid & 15) * 8, vst0 = v_st(sr, sc), vst1 = v_st(32 + sr, sc);
            const float* KV = (const float*)(ws + WS_KVS) + (size_t)(bh * 7) * 16384 + sc;
            f32x4 s[4][2];
#pragma unroll
            for (int q = 0; q < 4; ++q) { s[q][0] = f32x4{0.f, 0.f, 0.f, 0.f}; s[q][1] = f32x4{0.f, 0.f, 0.f, 0.f}; }
            const float g256 = __builtin_amdgcn_exp2f(256.0f * lg);
            for (int mm = 0; mm < qb; ++mm) {
                const float* p = KV + (size_t)mm * 16384;
#pragma unroll
                for (int q = 0; q < 4; ++q) { const int d = 32 * q + sr;
                    s[q][0] = s[q][0] * g256 + *(const f32x4*)(p + d * 128); s[q][1] = s[q][1] * g256 + *(const f32x4*)(p + d * 128 + 4); }
            }
#pragma unroll
            for (int q = 0; q < 4; ++q) { u32x4 w; w.x = cvtpk(s[q][0][0], s[q][0][1]); w.y = cvtpk(s[q][0][2], s[q][0][3]); w.z = cvtpk(s[q][1][0], s[q][1][1]); w.w = cvtpk(s[q][1][2], s[q][1][3]);
                *(u32x4*)(lds + (q >> 1) * SHM_V + ((q & 1) ? vst1 : vst0)) = w; }
        }
        __syncthreads();
        const float f = __builtin_amdgcn_exp2f((float)(wid * 32 + r32) * lg);
        bf16x8 qs[8];
#pragma unroll
        for (int d0 = 0; d0 < 8; ++d0) { const u32x4 w = *reinterpret_cast<const u32x4*>(&qr[d0]); u32x4 x;
            x.x = cvtpk(bflo(w.x) * f, bfhi(w.x) * f); x.y = cvtpk(bflo(w.y) * f, bfhi(w.y) * f); x.z = cvtpk(bflo(w.z) * f, bfhi(w.z) * f); x.w = cvtpk(bflo(w.w) * f, bfhi(w.w) * f);
            qs[d0] = *reinterpret_cast<const bf16x8*>(&x); }
        const int vb0 = (int)(uintptr_t)lds + v_rd_base(lane);
        pv_tile<0>(o, vb0, qs[0], qs[1], qs[2], qs[3]);
        pv_tile<1>(o, vb0, qs[4], qs[5], qs[6], qs[7]);
    }
    float rs[16];
#pragma unroll
    for (int r = 0; r < 16; ++r) rs[r] = 1.0f;
    __syncthreads();
    stage_o(lds, wid, o, rs, r32, hi);
    const bf16_t* srg = (const bf16_t*)(ws + WS_SRG) + ((size_t)b * SEQ + qlo) * 1024 + h * 128;
    bf16_t* y = (bf16_t*)(ws + WS_Y0) + ((size_t)b * SEQ + qlo) * DM + h * 128;
    int ln = lane; asm volatile("" : "+v"(ln));
#pragma unroll
    for (int i = 0; i < 8; ++i) { const int row = i * 4 + (ln >> 4), c = (ln & 15) * 8;
        float w[8], gt[8]; unpack8(ldo(lds, wid, i, ln), w); unpack8(*(const u32x4*)(srg + (size_t)row * 1024 + c), gt);
        float s = 0.f;
#pragma unroll
        for (int j = 0; j < 8; ++j) s += w[j] * w[j];
        s += __shfl_xor(s, 1); s += __shfl_xor(s, 2); s += __shfl_xor(s, 4); s += __shfl_xor(s, 8);
        const float rr = 1.0f / sqrtf(s * (1.0f / 128.0f) + EPS);
#pragma unroll
        for (int j = 0; j < 8; ++j) w[j] = w[j] * rr * gt[j];
        st16_wt(ws, y + (size_t)row * DM + c, pack8f(w)); }
}
namespace attw {
using namespace att;
constexpr int VT = 32768, KOFF = 65536, QOFF = 98304;
template <int VB>
__device__ __forceinline__ void pv_wide(f32x16* o, int vb0, bf16x8 pa0, bf16x8 pa1, bf16x8 pa2, bf16x8 pa3) {
#define TRRD(dst, off) asm volatile("ds_read_b64_tr_b16 %0, %1 offset:%2" : "=&v"(dst) : "v"(vb0), "i"(off) : "memory")
#define PV_LD(S, d0) do { constexpr int b_ = VB * VT + ((d0) >> 2) * 16384 + v_rd_off((d0) & 3, 0, 0); \
        TRRD(S##l0, b_); TRRD(S##h0, b_ + 2048); TRRD(S##l1, b_ + 4096); TRRD(S##h1, b_ + 6144); TRRD(S##l2, b_ + 8192); TRRD(S##h2, b_ + 10240); TRRD(S##l3, b_ + 12288); TRRD(S##h3, b_ + 14336); } while (0)
#define PV_MM(S, d0) do { \
        o[d0] = __builtin_amdgcn_mfma_f32_32x32x16_bf16(pa0, (bf16x8){S##l0[0], S##l0[1], S##l0[2], S##l0[3], S##h0[0], S##h0[1], S##h0[2], S##h0[3]}, o[d0], 0, 0, 0);   \
        o[d0] = __builtin_amdgcn_mfma_f32_32x32x16_bf16(pa1, (bf16x8){S##l1[0], S##l1[1], S##l1[2], S##l1[3], S##h1[0], S##h1[1], S##h1[2], S##h1[3]}, o[d0], 0, 0, 0);   \
        o[d0] = __builtin_amdgcn_mfma_f32_32x32x16_bf16(pa2, (bf16x8){S##l2[0], S##l2[1], S##l2[2], S##l2[3], S##h2[0], S##h2[1], S##h2[2], S##h2[3]}, o[d0], 0, 0, 0);   \
        o[d0] = __builtin_amdgcn_mfma_f32_32x32x16_bf16(pa3, (bf16x8){S##l3[0], S##l3[1], S##l3[2], S##l3[3], S##h3[0], S##h3[1], S##h3[2], S##h3[3]}, o[d0], 0, 0, 0); } while (0)
#define PV_STEP(Scur, Snext, d0) do { PV_LD(Snext, (d0) + 1); asm volatile("s_waitcnt lgkmcnt(8)" ::: "memory"); SBAR(); PV_MM(Scur, d0); SBAR(); } while (0)
    s16x4 Al0, Al1, Al2, Al3, Ah0, Ah1, Ah2, Ah3, Bl0, Bl1, Bl2, Bl3, Bh0, Bh1, Bh2, Bh3;
    PV_LD(A, 0);
    PV_STEP(A, B, 0); PV_STEP(B, A, 1); PV_STEP(A, B, 2); PV_STEP(B, A, 3); PV_STEP(A, B, 4); PV_STEP(B, A, 5); PV_STEP(A, B, 6);
    asm volatile("s_waitcnt lgkmcnt(0)" ::: "memory"); SBAR(); PV_MM(B, 7);
#undef PV_STEP
#undef PV_MM
#undef PV_LD
#undef TRRD
}
template <int KB>
__device__ __forceinline__ void qkt_q(f32x16& p0, f32x16& p1, const int (&ka)[4], const int (&qa)[4]) {
#define RD16(dst, addr, off) asm volatile("ds_read_b128 %0, %1 offset:%2" : "=&v"(dst) : "v"(addr), "i"(off) : "memory")
#define QK_LD(S, d0) do { RD16(S##q, qa[(d0) & 3], ((d0) >> 2) * 128); RD16(S##0, ka[(d0) & 3], KB * SHM_K + ((d0) >> 2) * 128); RD16(S##1, ka[(d0) & 3], KB * SHM_K + ((d0) >> 2) * 128 + 32 * 256); } while (0)
#define QK_MM(S) do { p0 = __builtin_amdgcn_mfma_f32_32x32x16_bf16(*reinterpret_cast<bf16x8*>(&S##0), *reinterpret_cast<bf16x8*>(&S##q), p0, 0, 0, 0); \
                      p1 = __builtin_amdgcn_mfma_f32_32x32x16_bf16(*reinterpret_cast<bf16x8*>(&S##1), *reinterpret_cast<bf16x8*>(&S##q), p1, 0, 0, 0); } while (0)
#define QK_STEP(Scur, Snext2, d0) do { QK_LD(Snext2, (d0) + 2); asm volatile("s_waitcnt lgkmcnt(6)" ::: "memory"); SBAR(); QK_MM(Scur); SBAR(); } while (0)
    u32x4 Aq, A0, A1, Bq, B0, B1, Cq, C0, C1;
    p0 = f32x16{}; p1 = f32x16{};
    QK_LD(A, 0); QK_LD(B, 1);
    QK_STEP(A, C, 0); QK_STEP(B, A, 1); QK_STEP(C, B, 2); QK_STEP(A, C, 3); QK_STEP(B, A, 4); QK_STEP(C, B, 5);
    asm volatile("s_waitcnt lgkmcnt(3)" ::: "memory"); SBAR(); QK_MM(A); SBAR();
    asm volatile("s_waitcnt lgkmcnt(0)" ::: "memory"); SBAR(); QK_MM(B);
#undef QK_STEP
#undef QK_MM
#undef QK_LD
#undef RD16
}
__device__ __forceinline__ void attn_wide(f32x16 (&o)[8], float& l_reg, const bf16_t* Qw, const bf16_t* __restrict__ Kh, const bf16_t* __restrict__ Vlo, const bf16_t* __restrict__ Vhi,
                                          int NT, int qlo, char* lds, LAS unsigned char* lds3, const int wv, const int var = 0) {
    const int tid = mk_tid(wv);
    const int wid = wv, lane = tid & 63, r32 = lane & 31, hi = lane >> 5;
    char* V_lds = lds; char* K_lds = lds + KOFF; char* Qw_lds = lds + QOFF + wid * 8192;
    float m_reg = -1e30f; l_reg = 0.f;
#pragma unroll
    for (int d = 0; d < 8; ++d) o[d] = f32x16{};
    const int vb0 = (int)(uintptr_t)V_lds + v_rd_base(lane);
    const int qm = qlo + r32 - 4 * hi;
    int koff[2], voff[2];
#pragma unroll
    for (int i = 0; i < 2; ++i) { const int ob = i * 8192 + wid * 1024 + lane * 16;
        const int row = ob >> 8, ch = ((ob >> 4) & 15) ^ (row & 7); koff[i] = row * D + ch * 8;
        const int st = ob >> 9, kk = (st >> 2) * 8 + ((ob & 511) >> 6), cc = (st & 3) * 32 + ((ob & 63) >> 1);
        const int key = (kk & ~0xC) | ((kk & 4) << 1) | ((kk & 8) >> 1); voff[i] = key * D + cc; }
    const unsigned ldsw = (unsigned)wid * 1024u;
    int ka[4], qa[4];
#pragma unroll
    for (int dd = 0; dd < 4; ++dd) { const int o_ = KSWZ(r32, (dd * 16 + hi * 8) * 2); ka[dd] = (int)(uintptr_t)K_lds + o_; qa[dd] = (int)(uintptr_t)Qw_lds + o_; }
#define GLDS(src, dstoff) __builtin_amdgcn_global_load_lds((const unsigned*)(src), (LAS unsigned*)(lds3 + (dstoff)), 16, 0, 0)
#define DMA_TILE(k0, bf) do { _Pragma("unroll") for (int i_ = 0; i_ < 2; ++i_) { \
        GLDS(Vlo + (size_t)(k0) * D + voff[i_], (bf) * VT + i_ * 8192 + ldsw); GLDS(Vhi + (size_t)(k0) * D + voff[i_], (bf) * VT + 16384 + i_ * 8192 + ldsw); \
        GLDS(Kh + (size_t)(k0) * D + koff[i_], KOFF + (bf) * SHM_K + i_ * 8192 + ldsw); } } while (0)
#define STEPW(t, B) do { f32x16 p0, p1; float mn, al; bf16x8 pa0, pa1, pa2, pa3; const int kb_ = (t) * KVBLK; \
        if ((t) + 1 < NT && !(var & 1)) DMA_TILE(((t) + 1) * KVBLK, (B) ^ 1); \
        SBAR(); if (!(var & 8)) qkt_q<B>(p0, p1, ka, qa); else { p0 = f32x16{}; p1 = f32x16{}; } \
        if (!(var & 2)) { \
        if (kb_ + KVBLK - 1 > qlo) mask_tile(p0, p1, qm - kb_, 0x40000000u); \
        partialSM(p0, p1, m_reg, mn, al); \
        if (__any(al < 1.f)) { for (int r = 0; r < 16; ++r) { const float f_ = __shfl(al, crow(r, hi)); for (int d_ = 0; d_ < 8; ++d_) o[d_][r] *= f_; } } \
        finishSM(p0, p1, al, l_reg, pa0, pa1, pa2, pa3); } else pack_p(p0, p1, pa0, pa1, pa2, pa3); SBAR(); \
        if (!(var & 4)) pv_wide<B>(o, vb0, pa0, pa1, pa2, pa3); \
        VMW(); __syncthreads(); } while (0)
    __syncthreads();
    DMA_TILE(0, 0);
    {
        bf16x8 qv[8];
#pragma unroll
        for (int i = 0; i < 8; ++i) { const int j = lane + 64 * i; qv[i] = *(const bf16x8*)(Qw + (size_t)(j >> 4) * D + (j & 15) * 8); }
#pragma unroll
        for (int i = 0; i < 8; ++i) { const int j = lane + 64 * i; *(bf16x8*)(Qw_lds + KSWZ(j >> 4, (j & 15) * 16)) = qv[i]; }
    }
    VMW(); __syncthreads();
    for (int t = 0; t < NT; t += 2) { STEPW(t, 0); STEPW(t + 1, 1); }
#undef STEPW
#undef DMA_TILE
#undef GLDS
}
}
__device__ __forceinline__ void diff_unit(unsigned char* ws, char* lds, int b, int h, int c, int qb, float lam, const bool fin, const int wv, const int var = 0) {
    using namespace att;
    const int wid = wv;
    const int qlo = qb * 256 + wid * 32;
    if (var & 16) return;
    const size_t hd = (size_t)(b * 16 + h * 2 + c) * SEQ;
    f32x16 o[8]; float rs[16]; float l_reg;
    attw::attn_wide(o, l_reg, (const bf16_t*)(ws + WS_Q1) + (hd + qlo) * 128, (const bf16_t*)(ws + WS_K1) + hd * 128, (const bf16_t*)(ws + WS_V1) + (size_t)(b * 16 + h * 2) * SEQ * 128, (const bf16_t*)(ws + WS_V1) + (size_t)(b * 16 + h * 2 + 1) * SEQ * 128,
                    4 * (qb + 1), qlo, lds, (LAS unsigned char*)lds, wv, var);
    const int tid = mk_tid(wv);
    const int lane = tid & 63, r32 = lane & 31, hi = lane >> 5;
    { const float il = 1.0f / l_reg;
#pragma unroll
      for (int r = 0; r < 16; ++r) rs[r] = __shfl(il, crow(r, hi)); }
    if (var & 32) { if (o[0][0] == 12345.f && l_reg == 777.f) *(float*)(ws + WS_CTL + 4096) = 1.f; return; }
    unsigned* cnt = (unsigned*)(ws + WS_CTL) + 512 + ((b * 8 + h) * 8 + qb);
    f32x16 (&olo)[4] = *reinterpret_cast<f32x16 (*)[4]>(&o[0]); f32x16 (&ohi)[4] = *reinterpret_cast<f32x16 (*)[4]>(&o[4]);
    if (!fin) {
        const __amdgpu_buffer_rsrc_t odr = __builtin_amdgcn_make_buffer_rsrc((void*)(ws + (c ? WS_OD1 : WS_OD)), 0, 32 << 20, 0x00020000);
        const unsigned odb = (unsigned)((((size_t)b * SEQ + qlo) * DM + h * 256) * 2);
        stage_o(lds, wid, olo, rs, r32, hi); copy_staged_wt(lds, wid, lane, odr, odb, DM * 2);
        stage_o(lds, wid, ohi, rs, r32, hi); copy_staged_wt(lds, wid, lane, odr, odb + 256, DM * 2);
        asm volatile("s_waitcnt vmcnt(0)" ::: "memory");
        __syncthreads();
        if (tid == 0) __hip_atomic_fetch_add(cnt, 1u, __ATOMIC_RELAXED, __HIP_MEMORY_SCOPE_AGENT);
    } else {
        stage_o(lds, wid, olo, rs, r32, hi); stage_o(lds + 65536, wid, ohi, rs, r32, hi);
        int ln = lane; asm volatile("" : "+v"(ln));
        const size_t e0 = ((size_t)b * SEQ + qlo + (ln >> 4)) * DM + h * 256 + (ln & 15) * 8;
        const bf16_t* sg = (const bf16_t*)(ws + WS_SG1) + e0; const bf16_t* rem = (const bf16_t*)(ws + (c ? WS_OD : WS_OD1)) + e0; bf16_t* y = (bf16_t*)(ws + WS_Y1) + e0;
        const float cl = c ? -lam : 1.0f, cr = c ? 1.0f : -lam;
        u32x4 g0[8], g1[8], q0[8], q1[8];
#pragma unroll
        for (int i = 0; i < 8; ++i) { g0[i] = *(const u32x4*)(sg + (size_t)(i * 4) * DM); g1[i] = *(const u32x4*)(sg + (size_t)(i * 4) * DM + 128); }
        if (tid == 0) { asm volatile("buffer_inv sc1" ::: "memory");
                        while (__hip_atomic_load(cnt, __ATOMIC_RELAXED, __HIP_MEMORY_SCOPE_AGENT) < 1u) __builtin_amdgcn_s_sleep(2);
                        asm volatile("s_waitcnt vmcnt(0)" ::: "memory"); }
        __syncthreads();
        if (!(var & 64)) {
#pragma unroll
        for (int i = 0; i < 8; ++i) { q0[i] = *(const u32x4*)(rem + (size_t)(i * 4) * DM); q1[i] = *(const u32x4*)(rem + (size_t)(i * 4) * DM + 128); }
#pragma unroll
        for (int i = 0; i < 8; ++i) {
            float L0[8], L1[8], R0[8], R1[8], G0[8], G1[8];
            unpack8(ldo(lds, wid, i, ln), L0); unpack8(ldo(lds + 65536, wid, i, ln), L1); unpack8(q0[i], R0); unpack8(q1[i], R1); unpack8(g0[i], G0); unpack8(g1[i], G1);
            float s = 0.f;
#pragma unroll
            for (int j = 0; j < 8; ++j) { L0[j] = cl * L0[j] + cr * R0[j]; L1[j] = cl * L1[j] + cr * R1[j]; s += L0[j] * L0[j] + L1[j] * L1[j]; }
            s += __shfl_xor(s, 1); s += __shfl_xor(s, 2); s += __shfl_xor(s, 4); s += __shfl_xor(s, 8);
            const float sc = (1.0f - LAMBDA_INIT) / sqrtf(s * (1.0f / 256.0f) + EPS);
#pragma unroll
            for (int j = 0; j < 8; ++j) { L0[j] = L0[j] * sc * G0[j]; L1[j] = L1[j] * sc * G1[j]; }
            *(u32x4*)(y + (size_t)(i * 4) * DM) = pack8f(L0); *(u32x4*)(y + (size_t)(i * 4) * DM + 128) = pack8f(L1); }
        }
    }
}

constexpr int NSA_SPLIT_TB = 16;
#ifndef CONV_EVERY
#define CONV_EVERY 3
#endif
constexpr int NQITEMS = 224 + 8 * NSA_SPLIT_TB + 2 * 8 * (32 - NSA_SPLIT_TB) + NCONV + 256;
struct ItemTable { unsigned short v[NQITEMS]; };
constexpr int nsa_cost(int tb) { return 10 * (4 + (tb + 1) + ((tb + 1) < 9 ? (tb + 1) : 9)); }
constexpr int nsaA_cost(int tb) { return 10 * (4 + (tb + 1)) + 5; }
constexpr int nsaB_cost(int tb) { return 10 * (1 + ((tb + 1) < 9 ? (tb + 1) : 9)) + 3; }
constexpr ItemTable make_items() {
    unsigned short w[NQITEMS] = {}; int m_ = 0;
    for (int m = 0; m < 7; ++m) for (int bh = 0; bh < 32; ++bh) w[m_++] = (unsigned short)(0x4000 | (bh << 3) | m);
    for (int c = 600; c >= 0; --c)
        for (int tb = 31; tb >= 0; --tb) {
            if (tb < NSA_SPLIT_TB) { if (nsa_cost(tb) == c) for (int bg = 0; bg < 8; ++bg) w[m_++] = (unsigned short)((bg << 5) | tb); }
            else { if (nsaA_cost(tb) == c) for (int bg = 0; bg < 8; ++bg) w[m_++] = (unsigned short)((1 << 8) | (bg << 5) | tb);
                   if (nsaB_cost(tb) == c) for (int bg = 0; bg < 8; ++bg) w[m_++] = (unsigned short)((2 << 8) | (bg << 5) | tb); }
        }
    ItemTable t{}; int n = 0, cv = 0;
    for (int i = 0; i < m_; ++i) { t.v[n++] = w[i]; if ((i % CONV_EVERY) == CONV_EVERY - 1 && cv < NCONV) t.v[n++] = (unsigned short)(0x2000 | cv++); }
    while (cv < NCONV) t.v[n++] = (unsigned short)(0x2000 | cv++);
    for (int qb = 7; qb >= 0; --qb) for (int bh = 0; bh < 32; ++bh) t.v[n++] = (unsigned short)(0x8000 | (bh << 3) | qb);
    return t;
}
__device__ const ItemTable P3_ITEMS = make_items();
constexpr double log2_1m(double x) { double s = 0, p = x; for (int n = 1; n <= 12; ++n) { s += p / n; p *= x; } return -s * 1.4426950408889634074; }
constexpr double pow2neg(int e) { double v = 1; for (int i = 0; i < e; ++i) v *= 0.5; return v; }


#define XB_TMO      128
#define XB_XCNT(j)  (256  + 64 * (j))
#define XB_XSUB(j)  (1280 + 64 * (j))
#define XB_XGEN(j)  (2304 + 64 * (j))
#define XB_TOP      3328
#define XB_TOPGEN   3392
#define XB_SPIN_CAP (1u << 18)
__device__ __forceinline__ unsigned xb_ld(unsigned* p)              { return __hip_atomic_load(p, __ATOMIC_RELAXED, __HIP_MEMORY_SCOPE_AGENT); }
__device__ __forceinline__ unsigned xb_add(unsigned* p, unsigned v) { return __hip_atomic_fetch_add(p, v, __ATOMIC_RELAXED, __HIP_MEMORY_SCOPE_AGENT); }
__device__ __forceinline__ unsigned xb_xcc_id() { return (unsigned)__builtin_amdgcn_s_getreg((3 << 11) | 20) & 0xFu; }
#define XB_SPIN(cond, bar) do { unsigned _sp = 0; while (cond) { __builtin_amdgcn_s_sleep(1); \
    if ((++_sp & 255u) == 0u) { if (xb_ld(&(bar)[XB_TMO])) break; if (_sp > XB_SPIN_CAP) { atomicAdd(&(bar)[XB_TMO], 1u); break; } } } } while (0)
__device__ __forceinline__ void xcd_barrier(unsigned* bar, unsigned x, unsigned nloc, unsigned nx, bool leader) {
    asm volatile("s_waitcnt vmcnt(0)" ::: "memory");
    __syncthreads();
    if (leader) {
        __builtin_amdgcn_s_waitcnt(0);
        const unsigned old = xb_add(&bar[XB_XSUB(x)], 1u);
        const unsigned gen = old / nloc;
        if (old + 1u == (gen + 1u) * nloc) {
            __builtin_amdgcn_fence(__ATOMIC_RELEASE, "agent");
            asm volatile("s_waitcnt vmcnt(0)" ::: "memory");
            const unsigned og = xb_add(&bar[XB_TOP], 1u);
            const unsigned tg = og / nx;
            if (og + 1u == (tg + 1u) * nx) xb_add(&bar[XB_TOPGEN], 1u);
            else XB_SPIN(xb_ld(&bar[XB_TOPGEN]) == tg, bar);
            __builtin_amdgcn_fence(__ATOMIC_ACQUIRE, "agent");
            xb_add(&bar[XB_XGEN(x)], 1u);
            asm volatile("s_waitcnt vmcnt(0)" ::: "memory");
        } else {
            XB_SPIN(xb_ld(&bar[XB_XGEN(x)]) == gen, bar);
            __builtin_amdgcn_fence(__ATOMIC_ACQUIRE, "agent");
            asm volatile("s_waitcnt vmcnt(0)" ::: "memory");
        }
    }
    __syncthreads();
}
#ifndef SEAM_EARLY_INV
#define SEAM_EARLY_INV 1
#endif
__device__ __forceinline__ void xcd_barrier_seam(unsigned* bar, unsigned x, unsigned nloc, unsigned nx, bool leader, unsigned k) {
    asm volatile("s_waitcnt vmcnt(0)" ::: "memory");
    __syncthreads();
    if (leader) {
        __builtin_amdgcn_s_waitcnt(0);
        const unsigned old = xb_add(&bar[XB_XSUB(x)], 1u);
        if (old + 1u == (k + 1u) * nloc) {
            __builtin_amdgcn_fence(__ATOMIC_RELEASE, "agent");
            asm volatile("s_waitcnt vmcnt(0)" ::: "memory");
            (void)xb_add(&bar[XB_TOP], 1u);
        }
        const unsigned tgt = (k + 1u) * nx;
#if SEAM_EARLY_INV
        asm volatile("buffer_inv sc1" ::: "memory");
        XB_SPIN(xb_ld(&bar[XB_TOP]) < tgt, bar);
        asm volatile("s_waitcnt vmcnt(0)" ::: "memory");
#else
        XB_SPIN(xb_ld(&bar[XB_TOP]) < tgt, bar);
        __builtin_amdgcn_fence(__ATOMIC_ACQUIRE, "agent");
        asm volatile("s_waitcnt vmcnt(0)" ::: "memory");
#endif
    }
    __syncthreads();
}
#ifndef G_ALIGN_BIG
#define G_ALIGN_BIG true
#endif
#ifndef G_SP2_BIG
#define G_SP2_BIG true
#endif
#ifndef G_ALIGN_ONE
#define G_ALIGN_ONE true
#endif
#ifndef G_SP2_ONE
#define G_SP2_ONE true
#endif
struct Args { const float* in[21]; float* out; unsigned char* ws; int ph_lo, ph_hi;
#ifdef PROBE_VAR
    int variant;
#endif
};
#ifdef PROBE_VAR
#define PVAR (args.variant)
#else
#define PVAR 0
#endif
constexpr int NPHASE = 7;

__global__ void __launch_bounds__(512, 2) mega_fwd(Args args) {
    extern __shared__ __attribute__((aligned(16))) unsigned char lds_raw[];
    LAS unsigned char* lds3 = (LAS unsigned char*)lds_raw;
    char* lds = (char*)lds_raw;
    cg::grid_group grid = cg::this_grid();
    unsigned char* ws = args.ws;
    const int wv = __builtin_amdgcn_readfirstlane(threadIdx.x >> 6);
#define FRESH_TID() const int tid = mk_tid(wv); const int lane = tid & 63, wave = wv; (void)lane; (void)wave
    const int G = gridDim.x, bx = blockIdx.x;
    const int vcu = (G % 8 == 0) ? (bx % 8) * (G / 8) + bx / 8 : bx;
    const int lo = args.ph_lo, hi_ph = args.ph_hi;
    const float* cosT = (const float*)(ws + WS_COS); const float* sinT = (const float*)(ws + WS_SIN);
#ifndef PHASE_MASK
#define PHASE_MASK 0x7f
#endif
#define IN(k) (((PHASE_MASK >> (k)) & 1) && lo <= (k) && (k) < hi_ph)
    unsigned nbar = 0;
#define BARRIER_ONLY() do { ++nbar; \
        asm volatile("s_waitcnt vmcnt(0)" ::: "memory"); __syncthreads(); \
        if (mk_tid(wv) == 0) { unsigned* ctr_ = (unsigned*)(ws + WS_CTL) + 64; \
            __builtin_amdgcn_fence(__ATOMIC_RELEASE, "agent"); asm volatile("s_waitcnt vmcnt(0)" ::: "memory"); \
            __hip_atomic_fetch_add(ctr_, 1u, __ATOMIC_RELAXED, __HIP_MEMORY_SCOPE_AGENT); \
            const unsigned want_ = nbar * (unsigned)G; unsigned sp_ = 0; \
            while (__hip_atomic_load(ctr_, __ATOMIC_RELAXED, __HIP_MEMORY_SCOPE_AGENT) < want_) { __builtin_amdgcn_s_sleep(2); if (++sp_ > (1u << 23)) break; } \
            __builtin_amdgcn_fence(__ATOMIC_ACQUIRE, "agent"); asm volatile("s_waitcnt vmcnt(0)" ::: "memory"); } \
        __syncthreads(); } while (0)
#ifndef REPEAT_MASK
#define REPEAT_MASK 0
#endif
#define NREP(k) (1 + ((REPEAT_MASK >> (k)) & 1))
    if (args.ph_hi < 0) grid.sync();
#define XBAR ((unsigned*)(ws + WS_CTL) + 2048)
    if (mk_tid(wv) == 0) (void)xb_add(&XBAR[XB_XCNT(xb_xcc_id())], 1u);
    unsigned xb_nloc = 1u, xb_nx = 1u;
#define SEAM(k) do { if (IN(k) && IN((k) + 1)) xcd_barrier_seam(XBAR, xb_xcc_id(), xb_nloc, xb_nx, mk_tid(wv) == 0, (unsigned)(k)); } while (0)

    for (int rep_ = 0; rep_ < NREP(0); ++rep_) {
    if (rep_ > 0) { const int k_save = 0; (void)k_save; BARRIER_ONLY(); }
    if (IN(0)) {
        FRESH_TID();
        PrepIn I; I.x = args.in[0]; I.g0 = args.in[1]; I.w0in = args.in[2]; I.w0out = args.in[3]; I.pek = args.in[6]; I.w1k = args.in[7]; I.w2k = args.in[8];
        I.pev = args.in[9]; I.w1v = args.in[10]; I.w2v = args.in[11]; I.g1 = args.in[12]; I.w1in = args.in[13]; I.w1out = args.in[14];
        I.lq1 = args.in[17]; I.lk1 = args.in[18]; I.lq2 = args.in[19]; I.lk2 = args.in[20];
        p0_prep(I, ws, lds3, vcu * 8 + wave, G * 8, wave, lane);
    }
    }
    if (IN(0) && IN(1) && wv == 0) {
        const unsigned xb_x = xb_xcc_id(); unsigned sum_, cnt_, mine_, sp_ = 0u;
        for (;;) { sum_ = 0u; cnt_ = 0u; mine_ = 0u;
#pragma unroll
            for (unsigned j_ = 0; j_ < 16; ++j_) { const unsigned c_ = xb_ld(&XBAR[XB_XCNT(j_)]); sum_ += c_; cnt_ += (c_ > 0u) ? 1u : 0u; mine_ = (j_ == xb_x) ? c_ : mine_; }
            if (sum_ == (unsigned)G) break;
            __builtin_amdgcn_s_sleep(1);
            if ((++sp_ & 255u) == 0u) { if (xb_ld(&XBAR[XB_TMO])) break; if (sp_ > XB_SPIN_CAP) { atomicAdd(&XBAR[XB_TMO], 1u); break; } } }
        xb_nloc = (unsigned)__builtin_amdgcn_readfirstlane((int)(mine_ > 0u ? mine_ : 1u)); xb_nx = (unsigned)__builtin_amdgcn_readfirstlane((int)(cnt_ > 0u ? cnt_ : 1u));
    }
    SEAM(0);
    for (int rep_ = 0; rep_ < NREP(1); ++rep_) {
    if (rep_ > 0) { const int k_save = 0; (void)k_save; BARRIER_ONLY(); }
    if (IN(1)) {
        pg8::Gemm g{(const bf16_t*)(ws + WS_H0), (const bf16_t*)(ws + WS_W0T), MTOK, N0, DM}; pg8::StaticOrder S; S.init(MTOK, N0, G, bx);
        EpiL0In E{ws, args.in[4], args.in[5], EpiCommon{cosT, sinT, (LAS float*)(lds3 + LDS_XT)}};
        pg8::gemm_phase<EpiL0In, pg8::StaticOrder, G_ALIGN_BIG, G_SP2_BIG>(lds3, g, S, E, wv);
        { pg8::Unit ut; int nu = 0; while (S.next(nu, ut)) ++nu;
          const int nunits = (MTOK / 256) * (N0 / 256), maxu = (nunits + G - 1) / G, nidle = maxu * G - nunits;
          const bool sharer = (nidle == 0) || (nu < maxu);
          if (sharer) {
              const int rank = (nidle == 0) ? bx : bx - (G - nidle), nsh = (nidle == 0) ? G : nidle;
              if (mk_tid(wv) == 0) { const unsigned* ck = (const unsigned*)(ws + WS_CTL) + 256; unsigned sp_ = 0;
                  while (__hip_atomic_load(ck, __ATOMIC_RELAXED, __HIP_MEMORY_SCOPE_AGENT) < 64u) { __builtin_amdgcn_s_sleep(4); if (++sp_ > (1u << 22)) break; }
                  __builtin_amdgcn_fence(__ATOMIC_ACQUIRE, "agent"); asm volatile("s_waitcnt vmcnt(0)" ::: "memory"); }
              __syncthreads();
              for (int it = rank; it < 64; it += nsh) compress_item(ws, args.in[5], args.in[6], args.in[9], lds, it, wv);
          } }
    }
    }
    SEAM(1);
    for (int rep_ = 0; rep_ < NREP(2); ++rep_) {
    if (rep_ > 0) { const int k_save = 0; (void)k_save; BARRIER_ONLY(); }
    if (IN(2)) {
        FRESH_TID();
        unsigned* qctr = (unsigned*)(ws + WS_CTL) + rep_; LAS unsigned* slot = (LAS unsigned*)(lds3 + LDS_BYTES - 16);
        for (;;) {
            __syncthreads();
            if (tid == 0) *slot = atomicAdd(qctr, 1u);
            __syncthreads();
            const unsigned qi = *slot;
            if (qi >= (unsigned)NQITEMS) break;
            const unsigned code = P3_ITEMS.v[qi];
            if (PVAR & ((code & 0x2000u) ? 0x100 : (code & 0xC000u) ? 0x200 : 0x400)) continue;
            if (code & 0x2000u) {
                PrepIn I; I.w0out = args.in[3]; I.g1 = args.in[12]; I.w1in = args.in[13]; I.w1out = args.in[14];
                I.x = nullptr; I.g0 = nullptr; I.w0in = nullptr; I.pek = nullptr; I.w1k = nullptr; I.w2k = nullptr; I.pev = nullptr; I.w1v = nullptr; I.w2v = nullptr; I.lq1 = nullptr; I.lk1 = nullptr; I.lq2 = nullptr; I.lk2 = nullptr;
                conv_item(I, ws, lds3, (int)(code & 0x1fffu), wv);
            } else if (code & 0xC000u) {
                const int bh = (code >> 3) & 31, qb = code & 7, h = bh & 7;
                constexpr float LG0 = (float)log2_1m(pow2neg(5)), LG1 = (float)log2_1m(pow2neg(6)), LG2 = (float)log2_1m(pow2neg(7)), LG3 = (float)log2_1m(pow2neg(8));
                constexpr float LG4 = (float)log2_1m(pow2neg(9)), LG5 = (float)log2_1m(pow2neg(10)), LG6 = (float)log2_1m(pow2neg(11)), LG7 = (float)log2_1m(pow2neg(12));
                const float lg = h == 0 ? LG0 : h == 1 ? LG1 : h == 2 ? LG2 : h == 3 ? LG3 : h == 4 ? LG4 : h == 5 ? LG5 : h == 6 ? LG6 : LG7;
#ifndef P3_NO_RET
                if (code & 0x4000u) kv_unit(ws, lds, bh, qb, lg, wv); else ret_unit(ws, lds, bh, qb, lg, wv);
#endif
            } else {
#ifndef P3_NO_NSA
                nsa_unit(ws, lds, (code >> 5) & 7, code & 31, (code >> 8) & 3, wv);
#endif
            }
        }
    }
    }
    SEAM(2);
    for (int rep_ = 0; rep_ < NREP(3); ++rep_) {
    if (rep_ > 0) { const int k_save = 0; (void)k_save; BARRIER_ONLY(); }
    if (IN(3)) {
        pg8::Gemm g{(const bf16_t*)(ws + WS_Y0), (const bf16_t*)(ws + WS_W0OT), MTOK, DM, DM}; pg8::StaticOrder S; S.init(MTOK, DM, G, bx);
        EpiL0Out E{args.in[0], (bf16_t*)(ws + WS_X1B), (float*)(ws + WS_RSS1)};
        pg8::gemm_phase<EpiL0Out, pg8::StaticOrder, G_ALIGN_ONE, G_SP2_ONE>(lds3, g, S, E, wv);
    }
    }
    SEAM(3);
    for (int rep_ = 0; rep_ < NREP(4); ++rep_) {
    if (rep_ > 0) { const int k_save = 0; (void)k_save; BARRIER_ONLY(); }
    if (IN(4)) {
        pg8::Gemm g{(const bf16_t*)(ws + WS_X1B), (const bf16_t*)(ws + WS_W1T), MTOK, N1, DM}; pg8::StaticOrder S; S.init(MTOK, N1, G, bx);
        LAS float* rsl = (LAS float*)(lds3 + LDS_RS);
        FRESH_TID();
        { pg8::Unit u; const float* rss = (const float*)(ws + WS_RSS1);
          f32x4 pv[4][8]; bool have[4];
#pragma unroll
          for (int i = 0; i < 4; ++i) { have[i] = S.next(i, u);
              if (have[i] && tid < 256) { const f32x4* p = (const f32x4*)(rss + (size_t)(u.pm * 256 + tid) * 32);
#pragma unroll
                  for (int j = 0; j < 8; ++j) pv[i][j] = p[j]; } }
#pragma unroll
          for (int i = 0; i < 4; ++i) { if (have[i] && tid < 256) { float s = 0.f;
#pragma unroll
                  for (int j = 0; j < 8; ++j) { const f32x4 v = pv[i][j]; s += (v[0] + v[1]) + (v[2] + v[3]); }
                  rsl[i * 256 + tid] = 1.0f / sqrtf(s * (1.0f / DM) + EPS); } }
          __syncthreads(); }
        EpiL1In E{ws, args.in[15], args.in[16], EpiCommon{cosT, sinT, (LAS float*)(lds3 + LDS_XT)}, rsl, (PVAR & 0x800) ? 1 : 0};
        pg8::gemm_phase<EpiL1In, pg8::StaticOrder, G_ALIGN_BIG, G_SP2_BIG>(lds3, g, S, E, wv);
    }
    }
    SEAM(4);
    for (int rep_ = 0; rep_ < NREP(5); ++rep_) {
    if (rep_ > 0) { const int k_save = 0; (void)k_save; BARRIER_ONLY(); }
    if (IN(5)) {
        const float lam = *(const float*)(ws + WS_LAM);
        for (int id = bx; id < 256; id += G) {
            const int xcd = id & 7, slot = id >> 3, bhh = xcd * 4 + (slot >> 3), sub = slot & 7, cc = sub & 1, pr = sub >> 1;
#pragma unroll 1
            for (int k = 0; k < 2; ++k) diff_unit(ws, lds, bhh >> 3, bhh & 7, cc, k ? pr : 7 - pr, lam, (cc ^ k) == 0, wv, PVAR);
        }
    }
    }
    SEAM(5);
    if (IN(6)) {
        pg8::Gemm g{(const bf16_t*)(ws + WS_Y1), (const bf16_t*)(ws + WS_W1OT), MTOK, DM, DM}; pg8::StaticOrder S; S.init(MTOK, DM, G, bx);
        EpiL1Out E{args.out, (const bf16_t*)(ws + WS_X1B)};
        pg8::gemm_phase<EpiL1Out, pg8::StaticOrder, G_ALIGN_ONE, G_SP2_ONE>(lds3, g, S, E, wv);
    }
#undef IN
#undef SEAM
}


#ifdef DEBUG_SCAN
__global__ void scan_bf16(const unsigned short* p, size_t n, unsigned* flags, unsigned bit) {
    unsigned bad = 0;
    for (size_t i = (size_t)blockIdx.x * blockDim.x + threadIdx.x; i < n; i += (size_t)gridDim.x * blockDim.x) { const unsigned v = p[i]; if ((v & 0x7f80u) == 0x7f80u) bad = 1; }
    if (bad) atomicOr(flags, bit);
}
__global__ void scan_cols(const unsigned short* p, size_t rows, int stride, int c0, int c1, unsigned* flags, unsigned bit) {
    unsigned bad = 0; const int w = c1 - c0;
    for (size_t i = (size_t)blockIdx.x * blockDim.x + threadIdx.x; i < rows * w; i += (size_t)gridDim.x * blockDim.x) { const unsigned v = p[(i / w) * stride + c0 + (i % w)]; if ((v & 0x7f80u) == 0x7f80u) bad = 1; }
    if (bad) atomicOr(flags, bit);
}
__global__ void scan_f32(const float* p, size_t n, unsigned* flags, unsigned bit) {
    unsigned bad = 0;
    for (size_t i = (size_t)blockIdx.x * blockDim.x + threadIdx.x; i < n; i += (size_t)gridDim.x * blockDim.x) { const unsigned v = __float_as_uint(p[i]); if ((v & 0x7f800000u) == 0x7f800000u) bad = 1; }
    if (bad) atomicOr(flags, bit);
}
__global__ void dbg_final(float* out, size_t n, const unsigned* flags) {
    const unsigned f = *flags; float off = 0.f;
    if (f) { int k = 0; while (!((f >> k) & 1u)) ++k; off = (float)(k + 1); }
    for (size_t i = (size_t)blockIdx.x * blockDim.x + threadIdx.x; i < n; i += (size_t)gridDim.x * blockDim.x) { float v = out[i]; if ((__float_as_uint(v) & 0x7f800000u) == 0x7f800000u) v = 0.f; out[i] = v + off; }
}
#endif

#ifdef DEBUG_NSA
__global__ void __launch_bounds__(512) check_nsa(const unsigned char* ws, unsigned* res) {
    __shared__ float q[4][128]; __shared__ float sc[4][2048]; __shared__ float pc[4][128]; __shared__ float imp[32]; __shared__ float red[4][128]; __shared__ unsigned selmask;
    __shared__ float ocmp[4][128], oslc[4][128];
    const int smp = blockIdx.x, tid = threadIdx.x, r = tid >> 7, d = tid & 127;
    const int b = smp & 3, g = (smp >> 2) & 1;
    const int tl[16] = {0, 5, 30, 31, 47, 63, 64, 511, 512, 513, 1023, 1024, 1500, 1983, 1984, 2047};
    const int t = (smp >> 3) < 16 ? tl[smp >> 3] : ((smp * 977 + 131) & 2047);
    const int bg = b * 2 + g, hq = g * 4 + r;
    const unsigned short* NQ = (const unsigned short*)(ws + WS_NQ) + ((size_t)(b * 8 + hq) * SEQ + t) * 128;
    q[r][d] = bf2f(NQ[d]); __syncthreads();
    auto blockmax = [&](float v) { red[r][d] = v; __syncthreads(); for (int s = 64; s > 0; s >>= 1) { if (d < s) red[r][d] = fmaxf(red[r][d], red[r][d + s]); __syncthreads(); } float m = red[r][0]; __syncthreads(); return m; };
    auto blocksum = [&](float v) { red[r][d] = v; __syncthreads(); for (int s = 64; s > 0; s >>= 1) { if (d < s) red[r][d] += red[r][d + s]; __syncthreads(); } float m = red[r][0]; __syncthreads(); return m; };
    const unsigned short* KC = (const unsigned short*)(ws + WS_KCMP) + (size_t)bg * 128 * 128; const unsigned short* VC = (const unsigned short*)(ws + WS_VCMP) + (size_t)bg * 128 * 128;
    float s = -INFINITY;
    if (d < 127 && 16 * d + 31 <= t) { float a = 0.f; for (int k = 0; k < 128; ++k) a += q[r][k] * bf2f(KC[d * 128 + k]); s = a * RSQRT_HD; }
    float m = blockmax(s); float p = (s == -INFINITY) ? 0.f : expf(s - m); float l = blocksum(p); p = l > 0.f ? p / l : 0.f; pc[r][d] = p; __syncthreads();
    { float a = 0.f; for (int n = 0; n < 127; ++n) a += pc[r][n] * bf2f(VC[n * 128 + d]); ocmp[r][d] = a; }
    if (tid < 32) { float a = 0.f; for (int rr = 0; rr < 4; ++rr) for (int n = 4 * tid - 1; n <= 4 * tid + 3; ++n) if (n >= 0 && n < 127) a += pc[rr][n]; imp[tid] = a; }
    __syncthreads();
    if (tid == 0) { const int bt = t >> 6; float scv[32]; unsigned msk = 0;
        for (int j = 0; j < 32; ++j) { const int back = bt - j; const bool forced = (j == 0) || (back >= 0 && back < 2); scv[j] = forced ? 1e9f : (back >= 0 ? imp[j] : -1e9f); }
        for (int j = 0; j < 32; ++j) { int rank = 0; for (int i = 0; i < 32; ++i) rank += (scv[i] > scv[j] || (scv[i] == scv[j] && i < j)) ? 1 : 0; if (rank < 16) msk |= 1u << j; }
        selmask = msk; }
    __syncthreads();
    const unsigned short* KS = (const unsigned short*)(ws + WS_KS) + (size_t)bg * SEQ * 128; const unsigned short* VS = (const unsigned short*)(ws + WS_VS) + (size_t)bg * SEQ * 128;
    float mx = -INFINITY;
    for (int k = d; k < SEQ; k += 128) { float v = -INFINITY; if (k <= t && ((selmask >> (k >> 6)) & 1u)) { float a = 0.f; for (int e = 0; e < 128; ++e) a += q[r][e] * bf2f(KS[(size_t)k * 128 + e]); v = a * RSQRT_HD; } sc[r][k] = v; mx = fmaxf(mx, v); }
    m = blockmax(mx); float ls = 0.f;
    for (int k = d; k < SEQ; k += 128) { const float v = sc[r][k]; const float e = (v == -INFINITY) ? 0.f : expf(v - m); sc[r][k] = e; ls += e; }
    l = blocksum(ls);
    { float a = 0.f; for (int k = 0; k <= t; ++k) a += sc[r][k] * bf2f(VS[(size_t)k * 128 + d]); oslc[r][d] = a / l; }
    __syncthreads();
    const unsigned short* KW = (const unsigned short*)(ws + WS_KW) + (size_t)bg * SEQ * 128; const unsigned short* VW = (const unsigned short*)(ws + WS_VW) + (size_t)bg * SEQ * 128;
    mx = -INFINITY;
    for (int k = d; k < SEQ; k += 128) { float v = -INFINITY; if (k <= t && t - k < 512) { float a = 0.f; for (int e = 0; e < 128; ++e) a += q[r][e] * bf2f(KW[(size_t)k * 128 + e]); v = a * RSQRT_HD; } sc[r][k] = v; mx = fmaxf(mx, v); }
    m = blockmax(mx); ls = 0.f;
    for (int k = d; k < SEQ; k += 128) { const float v = sc[r][k]; const float e = (v == -INFINITY) ? 0.f : expf(v - m); sc[r][k] = e; ls += e; }
    l = blocksum(ls);
    float ow = 0.f; for (int k = 0; k <= t; ++k) ow += sc[r][k] * bf2f(VW[(size_t)k * 128 + d]); ow /= l;
    const float* gt = (const float*)(ws + WS_GATES) + ((size_t)b * SEQ + t) * 24 + hq;
    const float sg = bf2f(((const unsigned short*)(ws + WS_SNG))[((size_t)b * SEQ + t) * 1024 + hq * 128 + d]);
#ifndef CHK_BRANCH
#define CHK_BRANCH 7
#endif
    const float yref = (gt[0] * ocmp[r][d] + gt[8] * oslc[r][d] + gt[16] * ow) * sg;
    const float yfast = bf2f(((const unsigned short*)(ws + WS_Y0))[((size_t)b * SEQ + t) * DM + 1024 + hq * 128 + d]);
    const float e2 = blocksum((yfast - yref) * (yfast - yref)), n2 = blocksum(yref * yref);
    if (d == 0 && e2 > 0.03f * 0.03f * n2 + 1e-12f) atomicAdd(res, 1u);
}
__global__ void dbg_final2(float* out, size_t n, const unsigned* res) {
    const float off = 0.1f * (float)(*res);
    for (size_t i = (size_t)blockIdx.x * blockDim.x + threadIdx.x; i < n; i += (size_t)gridDim.x * blockDim.x) out[i] += off;
}
#endif
#ifndef MK_ONE_LAUNCH
#define MK_ONE_LAUNCH 1
#endif
extern "C" void kernel_launch(void* const* d_in, const int* in_sizes, int n_in, void* d_out, int out_size, void* d_ws, size_t ws_size, hipStream_t stream) {
    static int grid = 0;
    if (grid == 0) {
        if (n_in != 21 || out_size != MTOK * DM || ws_size < WS_END) { fprintf(stderr, "kernel_launch: unexpected shapes (n_in %d out %d ws %zu)\n", n_in, out_size, ws_size); grid = -1; return; }
        int dev = 0, cus = 0, per_cu = 0;
        if (hipGetDevice(&dev) != hipSuccess || hipDeviceGetAttribute(&cus, hipDeviceAttributeMultiprocessorCount, dev) != hipSuccess) { grid = -1; return; }
        if (hipFuncSetAttribute((const void*)mega_fwd, hipFuncAttributeMaxDynamicSharedMemorySize, LDS_BYTES) != hipSuccess) { fprintf(stderr, "kernel_launch: hipFuncSetAttribute failed\n"); grid = -1; return; }
        if (hipOccupancyMaxActiveBlocksPerMultiprocessor(&per_cu, (const void*)mega_fwd, 512, LDS_BYTES) != hipSuccess || per_cu < 1) { fprintf(stderr, "kernel_launch: occupancy query says %d\n", per_cu); per_cu = 1; }
        (void)hipGetLastError();
        grid = cus * 1;
        if (grid % 16 != 0) { fprintf(stderr, "kernel_launch: grid %d is not a multiple of 16 (the differential-attention partner wait needs that)\n", grid); grid = -1; return; }
        fprintf(stderr, "kernel_launch: grid %d (cus %d, per_cu %d)\n", grid, cus, per_cu);
    }
    if (grid < 0) return;
    (void)hipMemsetAsync((char*)d_ws + WS_CTL, 0, CTL_BYTES, stream);
    Args a{};
    for (int i = 0; i < 21; ++i) a.in[i] = (const float*)d_in[i];
    a.out = (float*)d_out; a.ws = (unsigned char*)d_ws;
#if MK_ONE_LAUNCH
    a.ph_lo = 0; a.ph_hi = NPHASE;
    void* kargs[] = {&a};
    hipError_t e = hipLaunchCooperativeKernel((const void*)mega_fwd, dim3(grid), dim3(512), kargs, LDS_BYTES, stream);
    if (e != hipSuccess) fprintf(stderr, "kernel_launch: cooperative launch failed: %s\n", hipGetErrorString(e));
#else
    for (int p = 0; p < NPHASE; ++p) { a.ph_lo = p; a.ph_hi = p + 1;
#ifdef ML_REPEAT
#ifdef PROBE_VAR
        if (p == ML_REPEAT) { Args a2 = a; a2.variant = PROBE_VAR; hipLaunchKernelGGL(mega_fwd, dim3(grid), dim3(512), LDS_BYTES, stream, a2); (void)hipMemsetAsync((char*)d_ws + WS_CTL, 0, CTL_BYTES, stream); }
        hipLaunchKernelGGL(mega_fwd, dim3(grid), dim3(512), LDS_BYTES, stream, a);
#else
        hipLaunchKernelGGL(mega_fwd, dim3(grid), dim3(512), LDS_BYTES, stream, a);
        if (p == ML_REPEAT) { (void)hipMemsetAsync((char*)d_ws + WS_CTL, 0, CTL_BYTES, stream); hipLaunchKernelGGL(mega_fwd, dim3(grid), dim3(512), LDS_BYTES, stream, a); }
#endif
#else
        hipLaunchKernelGGL(mega_fwd, dim3(grid), dim3(512), LDS_BYTES, stream, a);
#endif
#ifdef DEBUG_NSA
        if (p == 2) check_nsa<<<256, 512, 0, stream>>>((const unsigned char*)d_ws, (unsigned*)((unsigned char*)d_ws + WS_CTL) + 200);
        if (p == 6) dbg_final2<<<256, 512, 0, stream>>>((float*)d_out, (size_t)MTOK * DM, (const unsigned*)((unsigned char*)d_ws + WS_CTL) + 200);
#endif
#ifdef DEBUG_SCAN
        unsigned char* w = (unsigned char*)d_ws; unsigned* fl = (unsigned*)(w + WS_CTL) + 128;
        if (p == 0) { scan_bf16<<<256, 512, 0, stream>>>((const unsigned short*)(w + WS_H0), (size_t)MTOK * DM, fl, 1u);
                      scan_bf16<<<256, 512, 0, stream>>>((const unsigned short*)(w + WS_W0T), (size_t)N0 * DM, fl, 1u);
                      scan_f32<<<256, 512, 0, stream>>>((const float*)(w + WS_COS), (size_t)SEQ * 128, fl, 1u); }
        if (p == 1) { scan_bf16<<<256, 512, 0, stream>>>((const unsigned short*)(w + WS_L0), (size_t)60 * MiB, fl, 2u); scan_f32<<<256, 512, 0, stream>>>((const float*)(w + WS_GATES), (size_t)MTOK * 24, fl, 2u); }
        if (p == 2) { scan_bf16<<<256, 512, 0, stream>>>((const unsigned short*)(w + WS_KCMP), (size_t)2 * 8 * 128 * 128, fl, 4u); }
        if (p == 3) { for (int hh = 0; hh < 8; ++hh) scan_cols<<<256, 512, 0, stream>>>((const unsigned short*)(w + WS_Y0), MTOK, DM, hh * 128, hh * 128 + 128, fl, 1u << hh); }
        if (p == 4) { scan_bf16<<<256, 512, 0, stream>>>((const unsigned short*)(w + WS_X1B), (size_t)MTOK * DM, fl, 16u); }
        if (p == 5) { scan_bf16<<<256, 512, 0, stream>>>((const unsigned short*)(w + WS_Q1), (size_t)MTOK * DM, fl, 32u); scan_bf16<<<256, 512, 0, stream>>>((const unsigned short*)(w + WS_K1), (size_t)MTOK * DM, fl, 32u);
                      scan_bf16<<<256, 512, 0, stream>>>((const unsigned short*)(w + WS_V1), (size_t)MTOK * DM * 2, fl, 32u); }
        if (p == 6) { scan_bf16<<<256, 512, 0, stream>>>((const unsigned short*)(w + WS_OD), (size_t)MTOK * DM, fl, 64u); }
        if (p == 7) { dbg_final<<<256, 512, 0, stream>>>((float*)d_out, (size_t)MTOK * DM, fl + 1); }
#endif
    }
#endif
}
```

```cpp
#include <hip/hip_runtime.h>
#include <hip/hip_cooperative_groups.h>
#include <cstdio>
#include <cstdint>
namespace cg = cooperative_groups;

__device__ __forceinline__ int mk_tid(int wv) { int lane; asm volatile("v_mbcnt_lo_u32_b32 %0, -1, 0\n\tv_mbcnt_hi_u32_b32 %0, -1, %0" : "=v"(lane)); return wv * 64 + lane; }

namespace pg8 {
#define PG8_LAS __attribute__((address_space(3)))
typedef unsigned short bf16_t;
typedef short bf16x8 __attribute__((ext_vector_type(8)));
typedef float f32x4 __attribute__((ext_vector_type(4)));
typedef unsigned u32x4 __attribute__((ext_vector_type(4)));
constexpr int BM = 256, BK = 64, HALF = 128, HTB = HALF * BK * 2  , STAGE_BYTES = 8 * HTB, NXCD = 8, WGM = 8;

__host__ __device__ __forceinline__ int lds_byte(int r, int c) { const int st = (r >> 4) * 2 + (c >> 5), rr = r & 15, cc = c & 31, ob = rr * 64 + cc * 2; return st * 1024 + (ob ^ (((ob >> 9) & 1) << 5)); }
__host__ __device__ __forceinline__ void stage_rc(int b, int& R, int& C) { const int st = b / 1024, sb = b % 1024, swz = sb ^ (((sb >> 9) & 1) << 5); R = (st >> 1) * 16 + swz / 64; C = (st & 1) * 32 + (swz % 64) / 2; }
__host__ __device__ __forceinline__ int perm32(int rho) { const int n = rho >> 4, i = rho & 15; return 8 * (i >> 2) + 4 * n + (i & 3); }

struct Unit { int pm, pn; };
struct Gemm { const bf16_t* A; const bf16_t* Bt; int M, N, K; };

struct StaticOrder {
    int nM, nN, nwg, G, c;
    __host__ __device__ __forceinline__ void init(int M, int N, int G_, int c_) { nM = M / BM; nN = N / BM; nwg = nM * nN; G = G_; c = c_; }
    __host__ __device__ __forceinline__ bool next(int i, Unit& u) const {
        const long L = (long)i * G + c; if (L >= nwg) return false;
        int wgid = (int)L; { const int q = nwg / NXCD, r = nwg % NXCD, xcd = wgid % NXCD, off = wgid / NXCD; wgid = (xcd < r ? xcd * (q + 1) : r * (q + 1) + (xcd - r) * q) + off; }
        const int nig = WGM * nN, gid = wgid / nig, fm = gid * WGM, gsz = (nM - fm) < WGM ? (nM - fm) : WGM;
        u.pm = fm + ((wgid % nig) % gsz); u.pn = (wgid % nig) / gsz; return true;
    }
    __device__ __forceinline__ void a_ready(const Unit&) const {}
    __device__ __forceinline__ void done(const Unit&) const {}
};


template <class Epi, class Sched, bool ALIGN_EPI = false, bool SP2 = false>
__device__ __forceinline__ void gemm_phase(PG8_LAS unsigned char* lds, const Gemm g, const Sched& S, const Epi& E, const int wv) {
    int lane; asm volatile("v_mbcnt_lo_u32_b32 %0, -1, 0\n\tv_mbcnt_hi_u32_b32 %0, -1, %0" : "=v"(lane));
    const int wid = wv, tid = wid * 64 + lane, wr = wid >> 2, wc = wid & 3, fr = lane & 15, fq = lane >> 4;
    const int K = g.K, nt = K / BK;
    unsigned voffA[2], voffB[2];
#pragma unroll
    for (int i = 0; i < 2; ++i) { int R, C; stage_rc(tid * 16 + i * 8192, R, C); const int Rb = Epi::PERM ? ((R & ~31) + perm32(R & 31)) : R;
        voffA[i] = (unsigned)(R * K + C) * 2u; voffB[i] = (unsigned)(Rb * K + C) * 2u; }
    const size_t kstep = (size_t)(BK * 2);
    const size_t hstep = (size_t)HALF * K * 2;
    const size_t tstep = 2 * hstep;
    const unsigned ldsw = (unsigned)wid * 1024u;
    const int aoff = lds_byte(wr * 64 + fr, fq * 8), boff = lds_byte(wc * 32 + fr, fq * 8);
#define PG8_SA(b, h) (((b) * 2 + (h)) * HTB)
#define PG8_SB(b, h) ((4 + (b) * 2 + (h)) * HTB)
#define PG8_STAGE(bufoff, gbase, voff) do { _Pragma("unroll") for (int _i = 0; _i < 2; ++_i) \
        __builtin_amdgcn_global_load_lds((const unsigned*)((const char*)(gbase) + (voff)[_i]), (PG8_LAS unsigned*)(lds + (bufoff) + ldsw + _i * 8192), 16, 0, 0); } while (0)
#define PG8_LDA(dst, b, h) do { _Pragma("unroll") for (int m = 0; m < 4; ++m) _Pragma("unroll") for (int k = 0; k < 2; ++k) dst[m][k] = *(const PG8_LAS bf16x8*)(lds + PG8_SA(b, h) + aoff + m * 2048 + k * 1024); } while (0)
#define PG8_LDB(dst, b, h) do { _Pragma("unroll") for (int n = 0; n < 2; ++n) _Pragma("unroll") for (int k = 0; k < 2; ++k) dst[n][k] = *(const PG8_LAS bf16x8*)(lds + PG8_SB(b, h) + boff + n * 2048 + k * 1024); } while (0)
#define PG8_MMA(ai, bj, At, Bt) do { __builtin_amdgcn_s_setprio(1); _Pragma("unroll") for (int m = 0; m < 4; ++m) _Pragma("unroll") for (int n = 0; n < 2; ++n) _Pragma("unroll") for (int k = 0; k < 2; ++k) \
        acc[ai][bj][m][n] = __builtin_amdgcn_mfma_f32_16x16x32_bf16(Bt[n][k], At[m][k], acc[ai][bj][m][n], 0, 0, 0); __builtin_amdgcn_s_setprio(0); } while (0)
#define PG8_WAIT_V(n) asm volatile("s_waitcnt vmcnt(" #n ")" ::: "memory")
#define PG8_WAIT_L(n) asm volatile("s_waitcnt lgkmcnt(" #n ")" ::: "memory")
#define PG8_BAR __builtin_amdgcn_s_barrier()
#define PG8_SCHED __builtin_amdgcn_sched_barrier(0)
    Unit cur, nxt; int ui = 0;
    if (!S.next(0, cur)) return;
    f32x4 acc[2][2][4][2];
#pragma unroll
    for (int a = 0; a < 2; ++a)
#pragma unroll
        for (int b = 0; b < 2; ++b)
#pragma unroll
            for (int m = 0; m < 4; ++m)
#pragma unroll
                for (int n = 0; n < 2; ++n) acc[a][b][m][n] = (f32x4){0.f, 0.f, 0.f, 0.f};
    bf16x8 At[4][2], B0[2][2], B1[2][2];
    const char* cA = (const char*)g.A + (size_t)cur.pm * tstep; const char* cB = (const char*)g.Bt + (size_t)cur.pn * tstep;
    S.a_ready(cur);
    if constexpr (SP2) {
        PG8_STAGE(PG8_SB(0, 0), cB, voffB); PG8_STAGE(PG8_SB(0, 1), cB + hstep, voffB); PG8_STAGE(PG8_SA(0, 0), cA, voffA); PG8_STAGE(PG8_SA(0, 1), cA + hstep, voffA);
        if (wr == 1) PG8_BAR;
        PG8_WAIT_V(2); PG8_BAR;
        PG8_STAGE(PG8_SB(1, 0), cB + kstep, voffB); PG8_STAGE(PG8_SA(1, 0), cA + kstep, voffA); PG8_STAGE(PG8_SB(1, 1), cB + hstep + kstep, voffB);
        PG8_WAIT_V(6); PG8_BAR;
    } else {
        PG8_STAGE(PG8_SB(0, 0), cB, voffB); PG8_STAGE(PG8_SA(0, 0), cA, voffA); PG8_STAGE(PG8_SB(0, 1), cB + hstep, voffB); PG8_STAGE(PG8_SA(0, 1), cA + hstep, voffA);
        if (wr == 1) PG8_BAR;
        PG8_WAIT_V(4); PG8_BAR;
        PG8_STAGE(PG8_SB(1, 0), cB + kstep, voffB); PG8_STAGE(PG8_SA(1, 0), cA + kstep, voffA); PG8_STAGE(PG8_SB(1, 1), cB + hstep + kstep, voffB);
        PG8_WAIT_V(6); PG8_BAR;
    }
    for (;;) {
        const bool has_next = S.next(ui + 1, nxt);
        const char* nA = has_next ? (const char*)g.A + (size_t)nxt.pm * tstep : cA; const char* nB = has_next ? (const char*)g.Bt + (size_t)nxt.pn * tstep : cB;
        for (int t = 0; t < nt; t += 2) {
            const bool last = (t == nt - 2);
            const char* a1 = cA + (size_t)(t + 1) * kstep;
            const char* a2 = last ? nA : cA + (size_t)(t + 2) * kstep; const char* b2 = last ? nB : cB + (size_t)(t + 2) * kstep;
            const char* a3 = a2 + kstep; const char* b3 = b2 + kstep;
            if (last && has_next) S.a_ready(nxt);
            if constexpr (SP2) {
            PG8_LDB(B0, 0, 0); PG8_LDB(B1, 0, 1); PG8_SCHED; PG8_LDA(At, 0, 0); PG8_STAGE(PG8_SA(1, 1), a1 + hstep, voffA);
            PG8_WAIT_V(8); PG8_WAIT_L(0); PG8_BAR; PG8_MMA(0, 0, At, B0); PG8_MMA(0, 1, At, B1); PG8_BAR; PG8_SCHED;
            PG8_LDA(At, 0, 1); PG8_STAGE(PG8_SB(0, 0), b2, voffB); PG8_STAGE(PG8_SB(0, 1), b2 + hstep, voffB); PG8_STAGE(PG8_SA(0, 0), a2, voffA);
            PG8_WAIT_V(8); PG8_WAIT_L(0); PG8_BAR; PG8_MMA(1, 0, At, B0); PG8_MMA(1, 1, At, B1); PG8_BAR; PG8_SCHED;
            PG8_LDB(B0, 1, 0); PG8_LDB(B1, 1, 1); PG8_SCHED; PG8_LDA(At, 1, 0); PG8_STAGE(PG8_SA(0, 1), a2 + hstep, voffA);
            PG8_WAIT_V(8); PG8_WAIT_L(0); PG8_BAR; PG8_MMA(0, 0, At, B0); PG8_MMA(0, 1, At, B1); PG8_BAR; PG8_SCHED;
            PG8_LDA(At, 1, 1); PG8_STAGE(PG8_SB(1, 0), b3, voffB); PG8_STAGE(PG8_SB(1, 1), b3 + hstep, voffB); PG8_STAGE(PG8_SA(1, 0), a3, voffA);
            PG8_WAIT_V(8); PG8_WAIT_L(0); PG8_BAR; PG8_MMA(1, 0, At, B0); PG8_MMA(1, 1, At, B1); PG8_BAR; PG8_SCHED;
            } else {
            PG8_LDB(B0, 0, 0); PG8_SCHED; PG8_LDA(At, 0, 0); PG8_STAGE(PG8_SA(1, 1), a1 + hstep, voffA);
            PG8_WAIT_L(8); PG8_BAR; PG8_WAIT_L(0); PG8_MMA(0, 0, At, B0); PG8_BAR; PG8_SCHED;
            PG8_LDB(B1, 0, 1); PG8_STAGE(PG8_SB(0, 0), b2, voffB);
            PG8_BAR; PG8_WAIT_L(0); PG8_MMA(0, 1, At, B1); PG8_BAR;
            PG8_LDA(At, 0, 1); PG8_STAGE(PG8_SA(0, 0), a2, voffA);
            PG8_BAR; PG8_WAIT_L(0); PG8_MMA(1, 0, At, B0); PG8_BAR; PG8_SCHED;
            PG8_STAGE(PG8_SB(0, 1), b2 + hstep, voffB);
            PG8_WAIT_V(6); PG8_BAR; PG8_MMA(1, 1, At, B1); PG8_BAR;
            PG8_LDB(B0, 1, 0); PG8_SCHED; PG8_LDA(At, 1, 0); PG8_STAGE(PG8_SA(0, 1), a2 + hstep, voffA);
            PG8_WAIT_L(8); PG8_BAR; PG8_WAIT_L(0); PG8_MMA(0, 0, At, B0); PG8_BAR; PG8_SCHED;
            PG8_LDB(B1, 1, 1); PG8_STAGE(PG8_SB(1, 0), b3, voffB);
            PG8_BAR; PG8_WAIT_L(0); PG8_MMA(0, 1, At, B1); PG8_BAR;
            PG8_LDA(At, 1, 1); PG8_STAGE(PG8_SA(1, 0), a3, voffA);
            PG8_BAR; PG8_WAIT_L(0); PG8_MMA(1, 0, At, B0); PG8_BAR; PG8_SCHED;
            PG8_STAGE(PG8_SB(1, 1), b3 + hstep, voffB);
            PG8_WAIT_V(6); PG8_BAR; PG8_MMA(1, 1, At, B1); PG8_BAR;
            }
        }
        if constexpr (ALIGN_EPI) { if (wr == 0) PG8_BAR; }
        if constexpr (!Epi::AFTER_DRAIN) { E(acc, cur, wr, wc, fr, fq, ui); S.done(cur); }
        if (!has_next) break;
#pragma unroll
        for (int a = 0; a < 2; ++a)
#pragma unroll
            for (int b = 0; b < 2; ++b)
#pragma unroll
                for (int m = 0; m < 4; ++m)
#pragma unroll
                    for (int n = 0; n < 2; ++n) acc[a][b][m][n] = (f32x4){0.f, 0.f, 0.f, 0.f};
        cur = nxt; cA = nA; cB = nB; ++ui;
        if constexpr (ALIGN_EPI) { if (wr == 1) PG8_BAR; }
    }
    PG8_WAIT_V(0);
    if constexpr (!ALIGN_EPI) { if (wr == 0) PG8_BAR; }
    PG8_BAR;
    if constexpr (Epi::AFTER_DRAIN) { E.fused(acc, cur, wr, wc, fr, fq, lds, wid, lane); S.done(cur); }
#undef PG8_SA
#undef PG8_SB
#undef PG8_STAGE
#undef PG8_LDA
#undef PG8_LDB
#undef PG8_MMA
#undef PG8_WAIT_V
#undef PG8_WAIT_L
#undef PG8_BAR
#undef PG8_SCHED
}
}

#define LAS __attribute__((address_space(3)))
typedef unsigned short bf16_t;
typedef short bf16x8 __attribute__((ext_vector_type(8)));
typedef short s16x4 __attribute__((ext_vector_type(4)));
typedef float f32x4 __attribute__((ext_vector_type(4)));
typedef float f32x16 __attribute__((ext_vector_type(16)));
typedef unsigned u32x4 __attribute__((ext_vector_type(4)));
typedef unsigned u32x2 __attribute__((ext_vector_type(2)));

constexpr int BATCH = 4, SEQ = 2048, DM = 2048, MTOK = BATCH * SEQ;
constexpr int N0 = 7936, N0REAL = 7704, N1 = 8192;
constexpr float EPS = 1e-6f;
constexpr float LAMBDA_INIT = 0.35550906759096926f;
constexpr float RSQRT_HD = 0.08838834764831845f;

constexpr size_t MiB = (size_t)1 << 20;
constexpr size_t WS_CTL = 0, CTL_BYTES = 40960;
constexpr size_t WS_COS = 1 * MiB, WS_SIN = 1 * MiB + 512 * 1024;
constexpr size_t WS_CW2T = 2 * MiB;
constexpr size_t WS_PB = 2 * MiB + 64 * 1024;
constexpr size_t WS_LAM = 2 * MiB + 96 * 1024;
constexpr size_t WS_KCMP = 2 * MiB + 128 * 1024;
constexpr size_t WS_VCMP = 2 * MiB + 384 * 1024;
constexpr size_t WS_CW1T = 3 * MiB;
constexpr size_t WS_GATES = 5 * MiB;
constexpr size_t WS_RSS1 = 6 * MiB;
constexpr size_t WS_W0OT = 8 * MiB, WS_W1OT = 16 * MiB, WS_W1T = 24 * MiB, WS_W0T = 56 * MiB;
constexpr size_t WS_H0 = 89 * MiB;
constexpr size_t WS_L0 = 121 * MiB;
constexpr size_t WS_RQ = WS_L0, WS_RK = WS_L0 + 16 * MiB, WS_RV = WS_L0 + 32 * MiB, WS_SRG = WS_L0 + 48 * MiB, WS_NQ = WS_L0 + 64 * MiB;
constexpr size_t WS_KC = WS_L0 + 80 * MiB, WS_VC = WS_L0 + 84 * MiB, WS_KS = WS_L0 + 88 * MiB, WS_VS = WS_L0 + 92 * MiB, WS_KW = WS_L0 + 96 * MiB, WS_VW = WS_L0 + 100 * MiB;
constexpr size_t WS_SNG = WS_L0 + 104 * MiB;
constexpr size_t WS_Y0 = 89 * MiB;
constexpr size_t WS_NSCR = 56 * MiB;
constexpr size_t WS_X1B = 121 * MiB;
constexpr size_t WS_Q1 = 56 * MiB, WS_K1 = 89 * MiB, WS_V1 = 153 * MiB, WS_SG1 = 185 * MiB;
constexpr size_t WS_KVS = 241 * MiB;
constexpr size_t WS_OD = 217 * MiB;
constexpr size_t WS_OD1 = 24 * MiB;
constexpr size_t WS_Y1 = WS_OD;
constexpr size_t WS_END = 255 * MiB;

constexpr int LDS_BYTES = 163840;
constexpr int LDS_XT = 131072;
constexpr int LDS_RS = 131072 + 8192;

typedef float f32x2_t __attribute__((ext_vector_type(2))); typedef __bf16 bf16x2_t __attribute__((ext_vector_type(2)));
__device__ __forceinline__ unsigned cvtpk(float lo, float hi) { f32x2_t v = {lo, hi}; bf16x2_t b = __builtin_convertvector(v, bf16x2_t); return __builtin_bit_cast(unsigned, b); }
__device__ __forceinline__ float bf2f(unsigned short b) { return __uint_as_float(((unsigned)b) << 16); }
__device__ __forceinline__ float bflo(unsigned w) { return __uint_as_float(w << 16); }
__device__ __forceinline__ float bfhi(unsigned w) { return __uint_as_float(w & 0xffff0000u); }
__device__ __forceinline__ float silu_f(float x) { return x * __builtin_amdgcn_rcpf(1.0f + __expf(-x)); }
__device__ __forceinline__ float sigmoid_f(float x) { return __builtin_amdgcn_rcpf(1.0f + __expf(-x)); }
__device__ __forceinline__ float wave_sum(float v) {
#pragma unroll
    for (int o = 1; o < 64; o <<= 1) v += __shfl_xor(v, o);
    return v;
}
__host__ __device__ __forceinline__ int l1_block(int pn) { const int xp = pn >> 4, q = (pn >> 2) & 3, k = pn & 3; return ((q & 1) * 2 + (q >> 1)) * 8 + xp * 4 + k; }
__host__ __device__ __forceinline__ int dperm(int lc) { return 16 * (lc >> 5) + 8 * ((lc >> 3) & 1) + 4 * ((lc >> 4) & 1) + (lc & 3) + 64 * ((lc >> 2) & 1); }

struct EpiCommon {
    const float* cosT; const float* sinT; LAS float* xt;
};
__device__ __forceinline__ void st_pair(bf16_t* p, pg8::f32x4 a, pg8::f32x4 b, bool wt) {
    u32x2 w0, w1; w0.x = cvtpk(a[0], a[1]); w0.y = cvtpk(a[2], a[3]); w1.x = cvtpk(b[0], b[1]); w1.y = cvtpk(b[2], b[3]);
    if (wt) {
        __hip_atomic_store((unsigned long long*)p, (unsigned long long)w0.x | ((unsigned long long)w0.y << 32), __ATOMIC_RELAXED, __HIP_MEMORY_SCOPE_AGENT);
        __hip_atomic_store((unsigned long long*)(p + 64), (unsigned long long)w1.x | ((unsigned long long)w1.y << 32), __ATOMIC_RELAXED, __HIP_MEMORY_SCOPE_AGENT);
    } else { *(u32x2*)p = w0; *(u32x2*)(p + 64) = w1; }
}
__device__ __forceinline__ void st_wide(bf16_t* p, pg8::f32x4 a, pg8::f32x4 b) {
    const unsigned a0 = cvtpk(a[0], a[1]), a1 = cvtpk(a[2], a[3]), b0 = cvtpk(b[0], b[1]), b1 = cvtpk(b[2], b[3]);
    const auto rx = __builtin_amdgcn_permlane32_swap(a0, b0, false, false); const auto ry = __builtin_amdgcn_permlane32_swap(a1, b1, false, false);
    u32x4 w; w.x = rx[0]; w.y = ry[0]; w.z = rx[1]; w.w = ry[1];
    *(u32x4*)p = w;
}
enum { T_ROPE = 0, T_RAW = 1, T_SILU = 2, T_NORMROPE = 3, T_NGL = 4 };

__device__ __forceinline__ float xsum_fq(float s) {
    { const auto r = __builtin_amdgcn_permlane16_swap(__float_as_uint(s), __float_as_uint(s), false, false); s = __uint_as_float(r[0]) + __uint_as_float(r[1]); }
    { const auto r = __builtin_amdgcn_permlane32_swap(__float_as_uint(s), __float_as_uint(s), false, false); s = __uint_as_float(r[0]) + __uint_as_float(r[1]); }
    return s;
}
template <bool HAS_RS>
__device__ __forceinline__ void epi_heads(const pg8::f32x4 (&acc)[2][2][4][2], int pm, int wr, int wc, int fr, int fq, int type, bf16_t* dst, size_t sB, size_t sH, size_t sS, int h0,
                                          const float* g, const EpiCommon& C, const LAS float* rsl, float* gates, bool wt = false) {
    const int d0 = 16 * wc + 8 * (fq & 1) + 4 * (fq >> 1);
    const int dst0 = (fq >> 1) ? d0 + 60 : d0;
    if (type == T_NORMROPE) {
#pragma unroll
        for (int ai = 0; ai < 2; ++ai)
#pragma unroll
            for (int m = 0; m < 4; ++m) {
                const int rl = ai * 128 + wr * 64 + m * 16 + fr; const float rs = HAS_RS ? rsl[rl] : 1.0f;
#pragma unroll
                for (int bj = 0; bj < 2; ++bj) {
                    const pg8::f32x4 a = acc[ai][bj][m][0] * rs, b = acc[ai][bj][m][1] * rs;
                    float s = (a[0] * a[0] + a[1] * a[1]) + (a[2] * a[2] + a[3] * a[3]) + (b[0] * b[0] + b[1] * b[1]) + (b[2] * b[2] + b[3] * b[3]);
                    s = xsum_fq(s);
                    if (fq == 0) C.xt[(rl * 2 + bj) * 4 + wc] = s;
                }
            }
        asm volatile("s_waitcnt lgkmcnt(0)" ::: "memory"); __builtin_amdgcn_s_barrier(); asm volatile("" ::: "memory");
    }
    pg8::f32x4 g0 = {1.f, 1.f, 1.f, 1.f}, g1 = {1.f, 1.f, 1.f, 1.f};
    if (type == T_NORMROPE) { g0 = *(const pg8::f32x4*)(g + d0); g1 = *(const pg8::f32x4*)(g + d0 + 64); }
    pg8::f32x4 rf;
#pragma unroll
    for (int j = 0; j < 4; ++j) rf[j] = exp2f(-(float)(d0 + j) * 0.20762050593046014f) * 0.15915494309189535f;
#pragma unroll
    for (int ai = 0; ai < 2; ++ai)
#pragma unroll
        for (int m = 0; m < 4; ++m) {
            const int rl = ai * 128 + wr * 64 + m * 16 + fr, row = pm * 256 + rl, b = row >> 11, s = row & 2047;
            const float rs = HAS_RS ? rsl[rl] : 1.0f;
            pg8::f32x4 cs = {1.f, 1.f, 1.f, 1.f}, sn = {0.f, 0.f, 0.f, 0.f};
            if (type == T_ROPE || type == T_NORMROPE) {
#pragma unroll
                for (int j = 0; j < 4; ++j) { const float rev = __builtin_amdgcn_fractf((float)s * rf[j]); cs[j] = __builtin_amdgcn_cosf(rev); sn[j] = __builtin_amdgcn_sinf(rev); } }
#pragma unroll
            for (int bj = 0; bj < 2; ++bj) {
                pg8::f32x4 a = acc[ai][bj][m][0] * rs, bb = acc[ai][bj][m][1] * rs;
                if (type == T_NGL) {
                    if (bj == 0) {
#pragma unroll
                        for (int j = 0; j < 4; ++j) if (d0 + j < 24) gates[(size_t)row * 24 + d0 + j] = sigmoid_f(a[j]);
                    }
                    continue;
                }
                if (type == T_NORMROPE) {
                    const LAS float* x = C.xt + (rl * 2 + bj) * 4;
                    const float rr = __builtin_amdgcn_rsqf(((x[0] + x[1]) + (x[2] + x[3])) * (1.0f / 128.0f) + EPS);
                    a = a * rr * g0; bb = bb * rr * g1;
                }
                if (type == T_ROPE || type == T_NORMROPE) { const pg8::f32x4 o0 = a * cs - bb * sn, o1 = a * sn + bb * cs; a = o0; bb = o1; }
                if (type == T_SILU) {
#pragma unroll
                    for (int j = 0; j < 4; ++j) { a[j] = silu_f(a[j]); bb[j] = silu_f(bb[j]); }
                }
                if (wt) st_pair(dst + (size_t)b * sB + (size_t)(h0 + bj) * sH + (size_t)s * sS + d0, a, bb, true);
                else st_wide(dst + (size_t)b * sB + (size_t)(h0 + bj) * sH + (size_t)s * sS + dst0, a, bb);
            }
        }
}

#ifndef EPI_WT_ALL
#define EPI_WT_ALL false
#endif
#ifndef KCVC_IN_PHASE
#define KCVC_IN_PHASE false
#endif
struct EpiL0In {
    static constexpr bool PERM = true, AFTER_DRAIN = false;
    unsigned char* ws; const float* qg; const float* kg; EpiCommon C;
    __device__ __forceinline__ void operator()(const pg8::f32x4 (&acc)[2][2][4][2], const pg8::Unit& u, int wr, int wc, int fr, int fq, int) const {
        const int pn = u.pn; int type; bf16_t* dst; int nh = 8, h0; const float* g = nullptr; bool tokmajor = false;
        if (pn < 4) { type = T_ROPE; dst = (bf16_t*)(ws + WS_RQ); h0 = 2 * pn; }
        else if (pn < 8) { type = T_ROPE; dst = (bf16_t*)(ws + WS_RK); h0 = 2 * (pn - 4); }
        else if (pn < 12) { type = T_RAW; dst = (bf16_t*)(ws + WS_RV); h0 = 2 * (pn - 8); }
        else if (pn < 16) { type = T_SILU; dst = (bf16_t*)(ws + WS_SRG); h0 = 2 * (pn - 12); tokmajor = true; }
        else if (pn < 20) { type = T_NORMROPE; dst = (bf16_t*)(ws + WS_NQ); h0 = 2 * (pn - 16); g = qg; }
        else if (pn < 26) { const int k = pn - 20; nh = 2; h0 = 0; type = (k == 2 || k == 4) ? T_NORMROPE : T_RAW; g = kg;
            dst = (bf16_t*)(ws + (k == 0 ? WS_KC : k == 1 ? WS_VC : k == 2 ? WS_KS : k == 3 ? WS_VS : k == 4 ? WS_KW : WS_VW)); }
        else if (pn < 30) { type = T_SILU; dst = (bf16_t*)(ws + WS_SNG); h0 = 2 * (pn - 26); tokmajor = true; }
        else { type = T_NGL; dst = nullptr; h0 = 0; }
        const size_t sB = tokmajor ? (size_t)SEQ * 1024 : (size_t)nh * SEQ * 128, sH = tokmajor ? 128 : (size_t)SEQ * 128, sS = tokmajor ? 1024 : 128;
        epi_heads<false>(acc, u.pm, wr, wc, fr, fq, type, dst, sB, sH, sS, h0, g, C, nullptr, (float*)(ws + WS_GATES), EPI_WT_ALL || (KCVC_IN_PHASE && (pn == 20 || pn == 21)));
        if (KCVC_IN_PHASE && (pn == 20 || pn == 21)) {
            asm volatile("s_waitcnt vmcnt(0)" ::: "memory");
            __builtin_amdgcn_s_barrier(); asm volatile("" ::: "memory");
            if (wr == 0 && wc == 0 && fr == 0 && fq == 0)
                __hip_atomic_fetch_add((unsigned*)(ws + WS_CTL) + 256, 1u, __ATOMIC_RELAXED, __HIP_MEMORY_SCOPE_AGENT);
        }
    }
};
struct EpiL1In {
    static constexpr bool PERM = true, AFTER_DRAIN = false;
    unsigned char* ws; const float* qg; const float* kg; EpiCommon C; const LAS float* rsl; int skip;
    __device__ __forceinline__ void operator()(const pg8::f32x4 (&acc)[2][2][4][2], const pg8::Unit& u, int wr, int wc, int fr, int fq, int ui) const {
        if (skip) { if (acc[0][0][0][0][0] == 12345.678f) *(float*)(ws + WS_CTL + 4096) = 1.f; return; }
        const int pn = l1_block(u.pn); int type; bf16_t* dst; int h0; const float* g = nullptr; bool tokmajor = false;
        if (pn < 8) { type = T_NORMROPE; dst = (bf16_t*)(ws + WS_Q1); h0 = 2 * pn; g = qg; }
        else if (pn < 16) { type = T_NORMROPE; dst = (bf16_t*)(ws + WS_K1); h0 = 2 * (pn - 8); g = kg; }
        else if (pn < 24) { type = T_RAW; dst = (bf16_t*)(ws + WS_V1); h0 = 2 * (pn - 16); }
        else { type = T_SILU; dst = (bf16_t*)(ws + WS_SG1); h0 = 2 * (pn - 24); tokmajor = true; }
        const size_t sB = tokmajor ? (size_t)SEQ * 2048 : (size_t)16 * SEQ * 128, sH = tokmajor ? 128 : (size_t)SEQ * 128, sS = tokmajor ? 2048 : 128;
        epi_heads<true>(acc, u.pm, wr, wc, fr, fq, type, dst, sB, sH, sS, h0, g, C, rsl + ui * 256, nullptr, EPI_WT_ALL);
    }
};
struct EpiL0Out {
    static constexpr bool PERM = true, AFTER_DRAIN = false;
    const float* x; bf16_t* x1b; float* rss;
    __device__ __forceinline__ void operator()(const pg8::f32x4 (&acc)[2][2][4][2], const pg8::Unit& u, int wr, int wc, int fr, int fq, int) const {
#pragma unroll
        for (int ai = 0; ai < 2; ++ai) {
            pg8::f32x4 res[4][2][2];
#pragma unroll
            for (int m = 0; m < 4; ++m) { const int row = u.pm * 256 + ai * 128 + wr * 64 + m * 16 + fr;
#pragma unroll
                for (int bj = 0; bj < 2; ++bj) { const size_t off = (size_t)row * DM + u.pn * 256 + bj * 128 + wc * 32 + 8 * fq;
                    res[m][bj][0] = __builtin_nontemporal_load((const pg8::f32x4*)(x + off)); res[m][bj][1] = __builtin_nontemporal_load((const pg8::f32x4*)(x + off + 4)); } }
#pragma unroll
            for (int m = 0; m < 4; ++m) {
                const int row = u.pm * 256 + ai * 128 + wr * 64 + m * 16 + fr; float ss = 0.f;
#pragma unroll
                for (int bj = 0; bj < 2; ++bj) {
                    const size_t off = (size_t)row * DM + u.pn * 256 + bj * 128 + wc * 32 + 8 * fq;
                    const pg8::f32x4 a = acc[ai][bj][m][0] + res[m][bj][0], b = acc[ai][bj][m][1] + res[m][bj][1];
                    u32x4 w; w.x = cvtpk(a[0], a[1]); w.y = cvtpk(a[2], a[3]); w.z = cvtpk(b[0], b[1]); w.w = cvtpk(b[2], b[3]);
                    *(u32x4*)(x1b + off) = w;
                    ss += (a[0] * a[0] + a[1] * a[1]) + (a[2] * a[2] + a[3] * a[3]) + (b[0] * b[0] + b[1] * b[1]) + (b[2] * b[2] + b[3] * b[3]);
                }
                ss = xsum_fq(ss);
                if (fq == 0) rss[(size_t)row * 32 + u.pn * 4 + wc] = ss;
            }
        }
    }
};
struct EpiL1Out {
    static constexpr bool PERM = true, AFTER_DRAIN = false;
    float* out; const bf16_t* x1b;
    __device__ __forceinline__ void operator()(const pg8::f32x4 (&acc)[2][2][4][2], const pg8::Unit& u, int wr, int wc, int fr, int fq, int) const {
        u32x4 res[2][4][2];
#pragma unroll
        for (int ai = 0; ai < 2; ++ai)
#pragma unroll
            for (int m = 0; m < 4; ++m) { const int row = u.pm * 256 + ai * 128 + wr * 64 + m * 16 + fr;
#pragma unroll
                for (int bj = 0; bj < 2; ++bj) res[ai][m][bj] = __builtin_nontemporal_load((const u32x4*)(x1b + (size_t)row * DM + u.pn * 256 + bj * 128 + wc * 32 + 8 * fq)); }
#pragma unroll
        for (int ai = 0; ai < 2; ++ai)
#pragma unroll
            for (int m = 0; m < 4; ++m) {
                const int row = u.pm * 256 + ai * 128 + wr * 64 + m * 16 + fr;
#pragma unroll
                for (int bj = 0; bj < 2; ++bj) {
                    const size_t off = (size_t)row * DM + u.pn * 256 + bj * 128 + wc * 32 + 8 * fq;
                    const u32x4 w = res[ai][m][bj];
                    const pg8::f32x4 r0 = {bflo(w.x), bfhi(w.x), bflo(w.y), bfhi(w.y)}, r1 = {bflo(w.z), bfhi(w.z), bflo(w.w), bfhi(w.w)};
                    *(pg8::f32x4*)(out + off) = acc[ai][bj][m][0] + r0; *(pg8::f32x4*)(out + off + 4) = acc[ai][bj][m][1] + r1;
                }
            }
    }
};

__device__ __forceinline__ unsigned f2bf(float f) { unsigned u = __float_as_uint(f); return (u + 0x7fffu + ((u >> 16) & 1u)) >> 16; }
__device__ __forceinline__ unsigned pk2(float lo, float hi) { return f2bf(lo) | (f2bf(hi) << 16); }
struct PrepIn { const float *x, *g0, *w0in, *w0out, *pek, *w1k, *w2k, *pev, *w1v, *w2v, *g1, *w1in, *w1out, *lq1, *lk1, *lq2, *lk2; };
struct TItem { const float* W; bf16_t* WT; const float* gk; int K, Nw, kb, nb, mode, cs; f32x4 gka, gkb; };
constexpr int I_W0 = 32 * (N0 / 32), I_WO = 32 * 64, I_W1 = 32 * (N1 / 32), I_C1 = 64 * 4, I_C2 = 2 * 4;
constexpr int NITEMS_T = I_W0 + 2 * I_WO + I_W1 + 2 * I_C1 + 2 * I_C2;
__device__ __forceinline__ TItem t_decode(const PrepIn& I, unsigned char* ws, int it) {
    TItem t; t.gk = nullptr; t.mode = 0; t.cs = 0; int r = it;
    if (r < I_W0) { t.W = I.w0in; t.WT = (bf16_t*)(ws + WS_W0T); t.K = DM; t.Nw = N0REAL; t.kb = r / (N0 / 32); t.nb = r % (N0 / 32); t.mode = 1; t.cs = 1; return t; } r -= I_W0;
    if (r < I_WO) { t.W = I.w0out; t.WT = (bf16_t*)(ws + WS_W0OT); t.K = DM; t.Nw = DM; t.kb = r / 64; t.nb = r % 64; return t; } r -= I_WO;
    if (r < I_W1) { t.W = I.w1in; t.WT = (bf16_t*)(ws + WS_W1T); t.K = DM; t.Nw = N1; t.kb = r / (N1 / 32); t.nb = r % (N1 / 32); t.mode = 2; t.gk = I.g1; return t; } r -= I_W1;
    if (r < I_WO) { t.W = I.w1out; t.WT = (bf16_t*)(ws + WS_W1OT); t.K = DM; t.Nw = DM; t.kb = r / 64; t.nb = r % 64; return t; } r -= I_WO;
    if (r < I_C1) { t.W = I.w1k; t.WT = (bf16_t*)(ws + WS_CW1T); t.K = 4096; t.Nw = 128; t.kb = r / 4; t.nb = r % 4; t.cs = 2; return t; } r -= I_C1;
    if (r < I_C1) { t.W = I.w1v; t.WT = (bf16_t*)(ws + WS_CW1T) + 128 * 4096; t.K = 4096; t.Nw = 128; t.kb = r / 4; t.nb = r % 4; t.cs = 2; return t; } r -= I_C1;
    if (r < I_C2) { t.W = I.w2k; t.WT = (bf16_t*)(ws + WS_CW2T); t.K = 128; t.Nw = 128; t.kb = r / 4; t.nb = r % 4; return t; } r -= I_C2;
    t.W = I.w2v; t.WT = (bf16_t*)(ws + WS_CW2T) + 128 * 128; t.K = 128; t.Nw = 128; t.kb = r / 4; t.nb = r % 4; return t;
}
__device__ __forceinline__ void t_load(TItem& t, int lane, float (&v)[32]) {
    if (t.gk) { const f32x4* gp = (const f32x4*)(t.gk + 64 * t.kb + 8 * (lane & 7)); t.gka = gp[0]; t.gkb = gp[1]; }
    const int np = 32 * t.nb + 4 * (lane & 7);
    const int src = t.mode == 2 ? (l1_block(np >> 8) * 256 + (np & 128) + dperm(np & 127)) : t.mode ? ((np & ~127) + dperm(np & 127)) : np; const bool valid = src < t.Nw;
    const float* p = t.W + (size_t)(64 * t.kb + (lane >> 3)) * t.Nw + (valid ? src : 0);
#pragma unroll
    for (int i = 0; i < 8; ++i) { const f32x4 w = __builtin_nontemporal_load((const f32x4*)(p + (size_t)(8 * i) * t.Nw)); v[4 * i] = w[0]; v[4 * i + 1] = w[1]; v[4 * i + 2] = w[2]; v[4 * i + 3] = w[3]; }
}
__device__ __forceinline__ void t_store(const TItem& t, int lane, const float (&v)[32], LAS float* scr) {
    const int k0 = 64 * t.kb, n0 = 32 * t.nb, np = n0 + 4 * (lane & 7);
    const int src = t.mode == 2 ? (l1_block(np >> 8) * 256 + (np & 128) + dperm(np & 127)) : t.mode ? ((np & ~127) + dperm(np & 127)) : np; const bool valid = src < t.Nw;
    float sc = valid ? 1.0f : 0.0f; if (t.cs == 1 && src >= 1024 && src < 2048) sc = RSQRT_HD;
#pragma unroll
    for (int i = 0; i < 8; ++i) { const int kk = 8 * i + (lane >> 3);
#pragma unroll
        for (int j = 0; j < 4; ++j) scr[kk * 33 + 4 * (lane & 7) + j] = v[4 * i + j] * sc; }
    asm volatile("s_waitcnt lgkmcnt(0)" ::: "memory");
    const int c = lane & 7;
#pragma unroll
    for (int j = 0; j < 4; ++j) { const int n = (lane >> 3) + 8 * j; const LAS float* s = scr + (8 * c) * 33 + n;
        float e0 = s[0 * 33], e1 = s[1 * 33], e2 = s[2 * 33], e3 = s[3 * 33], e4 = s[4 * 33], e5 = s[5 * 33], e6 = s[6 * 33], e7 = s[7 * 33];
        if (t.gk) { e0 *= t.gka[0]; e1 *= t.gka[1]; e2 *= t.gka[2]; e3 *= t.gka[3]; e4 *= t.gkb[0]; e5 *= t.gkb[1]; e6 *= t.gkb[2]; e7 *= t.gkb[3]; }
        u32x4 o; o.x = pk2(e0, e1); o.y = pk2(e2, e3); o.z = pk2(e4, e5); o.w = pk2(e6, e7);
        const size_t off = (t.cs == 2) ? ((size_t)((((k0 + 8 * c) >> 4) * 4 + ((n0 + n) >> 5)) * 64 + (((k0 + 8 * c) >> 3) & 1) * 32 + ((n0 + n) & 31)) * 8) : ((size_t)(n0 + n) * t.K + k0 + 8 * c);
        *(u32x4*)(t.WT + off) = o; }
    asm volatile("s_waitcnt lgkmcnt(0)" ::: "memory");
}
__device__ __forceinline__ void p0_prep(const PrepIn& I, unsigned char* ws, LAS unsigned char* lds, int gw, int NGW, int wave, int lane) {
    LAS float* scr = (LAS float*)(lds + wave * 16384);
    {
        constexpr int NP0 = I_W0 + 2 * I_C1 + 2 * I_C2, SKIP = 2 * I_WO + I_W1;
#define P0IDX(i) ((i) < I_W0 ? (i) : (i) + SKIP)
        float va[32], vb[32], vc[32], vd[32]; TItem ta, tb, tc, td;
        const int i0 = gw, i1 = gw + NGW, i2 = gw + 2 * NGW, i3 = gw + 3 * NGW;
        const int i4 = (NGW != 2048) ? gw + 4 * NGW : (wave == 0) ? 4 * NGW + (gw >> 3) : (wave == 1) ? 4 * NGW + 256 + (gw >> 3) : NP0;
        if (i0 < NP0) { ta = t_decode(I, ws, P0IDX(i0)); t_load(ta, lane, va); }
        if (i1 < NP0) { tb = t_decode(I, ws, P0IDX(i1)); t_load(tb, lane, vb); }
        if (i2 < NP0) { tc = t_decode(I, ws, P0IDX(i2)); t_load(tc, lane, vc); }
        if (i3 < NP0) { td = t_decode(I, ws, P0IDX(i3)); t_load(td, lane, vd); }
        if (i0 < NP0) t_store(ta, lane, va, scr);
        if (i4 < NP0) { ta = t_decode(I, ws, P0IDX(i4)); t_load(ta, lane, va); }
        if (i1 < NP0) t_store(tb, lane, vb, scr);
        if (i2 < NP0) t_store(tc, lane, vc, scr);
        if (i3 < NP0) t_store(td, lane, vd, scr);
        if (i4 < NP0) t_store(ta, lane, va, scr);
        for (int it = i4 + NGW; it < NP0; it += NGW) { ta = t_decode(I, ws, P0IDX(it)); t_load(ta, lane, va); t_store(ta, lane, va, scr); }
#undef P0IDX
    }
    {
        const f32x4* gr = (const f32x4*)I.g0 + lane; f32x4 g[8];
#pragma unroll
        for (int j = 0; j < 8; ++j) g[j] = gr[64 * j];
        for (int m0 = gw; m0 < MTOK; m0 += 4 * NGW) {
            f32x4 v[4][8];
#pragma unroll
            for (int q = 0; q < 4; ++q) { const int m = m0 + q * NGW; if (m < MTOK) { const f32x4* xr = (const f32x4*)(I.x + (size_t)m * DM) + lane;
#pragma unroll
                for (int j = 0; j < 8; ++j) v[q][j] = __builtin_nontemporal_load(&xr[64 * j]); } }
#pragma unroll
            for (int q = 0; q < 4; ++q) { const int m = m0 + q * NGW; if (m < MTOK) { float s = 0.f;
#pragma unroll
                for (int j = 0; j < 8; ++j) s += (v[q][j][0] * v[q][j][0] + v[q][j][1] * v[q][j][1]) + (v[q][j][2] * v[q][j][2] + v[q][j][3] * v[q][j][3]);
                const float r = 1.0f / sqrtf(wave_sum(s) * (1.0f / DM) + EPS);
                u32x2* o = (u32x2*)((bf16_t*)(ws + WS_H0) + (size_t)m * DM) + lane;
#pragma unroll
                for (int j = 0; j < 8; ++j) { u32x2 w; w.x = cvtpk(v[q][j][0] * r * g[j][0], v[q][j][1] * r * g[j][1]); w.y = cvtpk(v[q][j][2] * r * g[j][2], v[q][j][3] * r * g[j][3]); o[64 * j] = w; } } }
        }
    }
    for (int e = gw * 64 + lane; e < SEQ * 64; e += NGW * 64) {
        const int pos = e >> 6, i = e & 63;
        const float inv = 1.0f / powf(10000.0f, (float)(2 * i) / 128.0f);
        const float angf = (float)pos * inv;
        const double a = (double)angf, k = rint(a * 0.15915494309189535), r = a - k * 6.283185307179586476925;
        const double r2 = r * r; double cs = 1.0, sn = r, tc = 1.0, ts = r;
#pragma unroll
        for (int n = 1; n <= 15; ++n) { tc *= -r2 / (double)((2 * n - 1) * (2 * n)); ts *= -r2 / (double)((2 * n) * (2 * n + 1)); cs += tc; sn += ts; }
        ((float*)(ws + WS_COS))[e] = (float)cs; ((float*)(ws + WS_SIN))[e] = (float)sn;
    }
    if (gw == NGW - 1) {
        const float a = wave_sum(I.lq1[lane] * I.lk1[lane] + I.lq1[lane + 64] * I.lk1[lane + 64]);
        const float b = wave_sum(I.lq2[lane] * I.lk2[lane] + I.lq2[lane + 64] * I.lk2[lane + 64]);
        if (lane == 0) *(float*)(ws + WS_LAM) = expf(a) - expf(b) + LAMBDA_INIT;
    }
}

constexpr int NCONV = (2 * I_WO + I_W1) / 64;
__device__ __forceinline__ void conv_item(const PrepIn& I, unsigned char* ws, LAS unsigned char* lds, int c, const int wv) {
    const int lane = mk_tid(wv) & 63;
    LAS float* scr = (LAS float*)(lds + wv * 16384);
    const int base = I_W0 + c * 64 + wv * 8;
    float va[32], vb[32], vc[32], vd[32]; TItem ta, tb, tc, td;
    ta = t_decode(I, ws, base); t_load(ta, lane, va); tb = t_decode(I, ws, base + 1); t_load(tb, lane, vb);
    tc = t_decode(I, ws, base + 2); t_load(tc, lane, vc); td = t_decode(I, ws, base + 3); t_load(td, lane, vd);
    t_store(ta, lane, va, scr); ta = t_decode(I, ws, base + 4); t_load(ta, lane, va);
    t_store(tb, lane, vb, scr); tb = t_decode(I, ws, base + 5); t_load(tb, lane, vb);
    t_store(tc, lane, vc, scr); tc = t_decode(I, ws, base + 6); t_load(tc, lane, vc);
    t_store(td, lane, vd, scr); td = t_decode(I, ws, base + 7); t_load(td, lane, vd);
    t_store(ta, lane, va, scr); t_store(tb, lane, vb, scr); t_store(tc, lane, vc, scr); t_store(td, lane, vd, scr);
}

namespace att {
constexpr int NW = 8, QBLK = 32, KVBLK = 64, D = 128;
constexpr int SHM_V = KVBLK * D * 2, SHM_K = KVBLK * D * 2;
constexpr int LDS_WS = 2 * SHM_V + 2 * SHM_K;
constexpr int LDS_IMP = LDS_WS + NW * 64 * 4;
constexpr int LDS_SC = LDS_IMP + 8 * 32 * 33 * 4;
constexpr int LDS_SELM = LDS_SC + 64 * 33 * 4;
constexpr float SCALE = 0.08838834764831845f, C2 = 1.4426950408889634f * SCALE, THR = 8.f;
#define KSWZ(row, colB) ((row) * 256 + ((colB) ^ (((row) & 7) << 4)))
#define SBAR() __builtin_amdgcn_sched_barrier(0)
__device__ __forceinline__ int v_st(int k, int c) { const int kk = (k & ~0xC) | ((k & 4) << 1) | ((k & 8) >> 1); return ((kk >> 3) * 4 + (c >> 5)) * 512 + ((kk & 7) * 32 + (c & 31)) * 2; }
__device__ __forceinline__ int v_rd_base(int lane) { return ((lane & 3) << 3) | (((lane >> 2) & 3) << 6) | (((lane >> 4) & 1) << 5) | (((lane >> 5) & 1) << 8); }
constexpr int v_rd_off(int d0, int ks, int half) { return d0 * 512 + ks * 4096 + half * 2048; }
__device__ __forceinline__ int crow(int r, int hi) { return (r & 3) + 8 * (r >> 2) + 4 * hi; }
__device__ __forceinline__ void mask_tile(f32x16& p0, f32x16& p1, int dq, unsigned W) {
    const float NEG = -__builtin_inff();
#pragma unroll
    for (int r = 0; r < 16; ++r) {
        const int c = (r & 3) + 8 * (r >> 2);
        if ((unsigned)(dq - c) >= W) p0[r] = NEG;
        if ((unsigned)(dq - c - 32) >= W) p1[r] = NEG;
    }
}
__device__ __forceinline__ void mask_all(f32x16& p0, f32x16& p1, bool keep) {
    const float NEG = -__builtin_inff();
#pragma unroll
    for (int r = 0; r < 16; ++r) { p0[r] = keep ? p0[r] : NEG; p1[r] = keep ? p1[r] : NEG; }
}
__device__ __forceinline__ void partialSM(f32x16& p0, f32x16& p1, float& m_reg, float& mn, float& alpha) {
    float pmax = p0[0];
#pragma unroll
    for (int r = 1; r < 16; ++r) pmax = fmaxf(pmax, p0[r]);
#pragma unroll
    for (int r = 0; r < 16; ++r) pmax = fmaxf(pmax, p1[r]);
    { auto rr = __builtin_amdgcn_permlane32_swap(__float_as_uint(pmax), __float_as_uint(pmax), false, false);
      pmax = fmaxf(__uint_as_float(rr[0]), __uint_as_float(rr[1])); }
    if (__builtin_expect(__all((pmax - m_reg) * SCALE <= THR), 1)) { mn = m_reg; alpha = 1.f; }
    else { mn = fmaxf(m_reg, pmax); alpha = __builtin_amdgcn_exp2f((m_reg - mn) * C2); m_reg = mn; }
    const float mnL = -mn * C2;
#pragma unroll
    for (int r = 0; r < 16; ++r) p0[r] = fmaf(p0[r], C2, mnL);
#pragma unroll
    for (int r = 0; r < 16; ++r) p1[r] = fmaf(p1[r], C2, mnL);
#pragma unroll
    for (int r = 0; r < 16; ++r) p0[r] = __builtin_amdgcn_exp2f(p0[r]);
}
#define PK4(P, B_, OUT) do { unsigned a0 = cvtpk(P[B_+0], P[B_+1]), a1 = cvtpk(P[B_+2], P[B_+3]);                          \
        unsigned b0 = cvtpk(P[B_+4], P[B_+5]), b1 = cvtpk(P[B_+6], P[B_+7]);                                             \
        auto r0 = __builtin_amdgcn_permlane32_swap(a0, b0, false, false); auto r1 = __builtin_amdgcn_permlane32_swap(a1, b1, false, false); \
        u32x4 w = {r0[0], r1[0], r0[1], r1[1]}; OUT = *reinterpret_cast<bf16x8*>(&w); } while (0)
__device__ __forceinline__ void pack_p(const f32x16& p0, const f32x16& p1, bf16x8& pa0, bf16x8& pa1, bf16x8& pa2, bf16x8& pa3) {
    PK4(p0, 0, pa0); PK4(p0, 8, pa1); PK4(p1, 0, pa2); PK4(p1, 8, pa3);
}
__device__ __forceinline__ void finishSM(f32x16& p0, f32x16& p1, float alpha, float& l_reg, bf16x8& pa0, bf16x8& pa1, bf16x8& pa2, bf16x8& pa3) {
#pragma unroll
    for (int r = 0; r < 16; ++r) p1[r] = __builtin_amdgcn_exp2f(p1[r]);
    float ps = 0;
#pragma unroll
    for (int r = 0; r < 16; ++r) ps += p0[r];
#pragma unroll
    for (int r = 0; r < 16; ++r) ps += p1[r];
    { auto rr = __builtin_amdgcn_permlane32_swap(__float_as_uint(ps), __float_as_uint(ps), false, false);
      ps = __uint_as_float(rr[0]) + __uint_as_float(rr[1]); }
    l_reg = l_reg * alpha + ps;
    pack_p(p0, p1, pa0, pa1, pa2, pa3);
}
__device__ __forceinline__ void decay_apply(f32x16& p0, f32x16& p1, int dq, float lg) {
#pragma unroll
    for (int r = 0; r < 16; ++r) {
        const int c = (r & 3) + 8 * (r >> 2); const int e0 = dq - c, e1 = dq - c - 32;
        const float w0 = __builtin_amdgcn_exp2f((float)e0 * lg), w1 = __builtin_amdgcn_exp2f((float)e1 * lg);
        p0[r] = e0 >= 0 ? p0[r] * w0 : 0.f; p1[r] = e1 >= 0 ? p1[r] * w1 : 0.f;
    }
}
__device__ __forceinline__ void decay_fast(f32x16& p0, f32x16& p1, int dq, float lg, const float (&dc)[16]) {
    const float a0 = __builtin_amdgcn_exp2f((float)dq * lg), a1 = a0 * __builtin_amdgcn_exp2f(-32.0f * lg);
#pragma unroll
    for (int r = 0; r < 16; ++r) { p0[r] *= a0 * dc[r]; p1[r] *= a1 * dc[r]; }
}
template <int KB>
__device__ __forceinline__ void qkt(f32x16& p0, f32x16& p1, const char* K_lds, int r32, int hi, const bf16x8* qr) {
    p0 = f32x16{}; p1 = f32x16{};
    const char* kb[4];
#pragma unroll
    for (int dd = 0; dd < 4; ++dd) kb[dd] = K_lds + KB * SHM_K + KSWZ(r32, (dd * 16 + hi * 8) * 2);
#pragma unroll
    for (int d0 = 0; d0 < 8; ++d0) { const char* a = kb[d0 & 3] + (d0 >> 2) * 128;
        bf16x8 b0 = *reinterpret_cast<const bf16x8*>(a);
        bf16x8 b1 = *reinterpret_cast<const bf16x8*>(a + 32 * 256);
        p0 = __builtin_amdgcn_mfma_f32_32x32x16_bf16(b0, qr[d0], p0, 0, 0, 0);
        p1 = __builtin_amdgcn_mfma_f32_32x32x16_bf16(b1, qr[d0], p1, 0, 0, 0); }
}
template <int VB>
__device__ __forceinline__ void pv_tile(f32x16* o, int vb0, bf16x8 pa0, bf16x8 pa1, bf16x8 pa2, bf16x8 pa3) {
#define TRRD(dst, off) asm volatile("ds_read_b64_tr_b16 %0, %1 offset:%2" : "=&v"(dst) : "v"(vb0), "i"(off) : "memory")
#define PV_D0(d0) do { s16x4 l0, l1, l2, l3, h0, h1, h2, h3; constexpr int b_ = VB * SHM_V + v_rd_off(d0, 0, 0); \
        TRRD(l0, b_); TRRD(h0, b_ + 2048); TRRD(l1, b_ + 4096); TRRD(h1, b_ + 6144); TRRD(l2, b_ + 8192); TRRD(h2, b_ + 10240); TRRD(l3, b_ + 12288); TRRD(h3, b_ + 14336); \
        asm volatile("s_waitcnt lgkmcnt(0)" ::: "memory"); SBAR();   \
        o[d0] = __builtin_amdgcn_mfma_f32_32x32x16_bf16(pa0, (bf16x8){l0[0], l0[1], l0[2], l0[3], h0[0], h0[1], h0[2], h0[3]}, o[d0], 0, 0, 0);   \
        o[d0] = __builtin_amdgcn_mfma_f32_32x32x16_bf16(pa1, (bf16x8){l1[0], l1[1], l1[2], l1[3], h1[0], h1[1], h1[2], h1[3]}, o[d0], 0, 0, 0);   \
        o[d0] = __builtin_amdgcn_mfma_f32_32x32x16_bf16(pa2, (bf16x8){l2[0], l2[1], l2[2], l2[3], h2[0], h2[1], h2[2], h2[3]}, o[d0], 0, 0, 0);   \
        o[d0] = __builtin_amdgcn_mfma_f32_32x32x16_bf16(pa3, (bf16x8){l3[0], l3[1], l3[2], l3[3], h3[0], h3[1], h3[2], h3[3]}, o[d0], 0, 0, 0); } while (0)
    PV_D0(0); PV_D0(1); PV_D0(2); PV_D0(3);
#undef PV_D0
#undef TRRD
}
#define VMW() asm volatile("s_waitcnt vmcnt(0)" ::: "memory")

template <int MODE>
__device__ __forceinline__ void attn_core(f32x16 (&o)[4], float& l_reg, const bf16x8 (&qr)[8], const bf16_t* __restrict__ Kh, const bf16_t* __restrict__ Vh,
                                          int j_lo, int NT, int qlo, int W, unsigned selm, bool use_sel, float lg, char* lds, const int wv) {
    const int tid = mk_tid(wv);
    const int wid = wv, lane = tid & 63, r32 = lane & 31, hi = lane >> 5;
    char* V_lds = lds; char* K_lds = lds + 2 * SHM_V;
    float* ws = (float*)(lds + LDS_WS) + wid * 64; float* al_l = ws + 32;
    float m_reg = -1e30f; l_reg = 0.f;
#pragma unroll
    for (int d = 0; d < 4; ++d) o[d] = f32x16{};
    const int vb0 = (int)(uintptr_t)V_lds + v_rd_base(lane);
    const int qm = qlo + r32 - 4 * hi;
    LAS unsigned char* lds3 = (LAS unsigned char*)lds;
    int koff[2], voff[2];
#pragma unroll
    for (int i = 0; i < 2; ++i) { const int ob = i * 8192 + wid * 1024 + lane * 16;
        const int row = ob >> 8, ch = ((ob >> 4) & 15) ^ (row & 7); koff[i] = row * D + ch * 8;
        const int st = ob >> 9, kk = (st >> 2) * 8 + ((ob & 511) >> 6), cc = (st & 3) * 32 + ((ob & 63) >> 1);
        const int key = (kk & ~0xC) | ((kk & 4) << 1) | ((kk & 8) >> 1); voff[i] = key * D + cc; }
    const unsigned ldsw = (unsigned)wid * 1024u;
#define KBASE(t) ((j_lo + (t)) * KVBLK)
#define GLDS(src, dstoff) __builtin_amdgcn_global_load_lds((const unsigned*)(src), (LAS unsigned*)(lds3 + (dstoff)), 16, 0, 0)
#define DMA_K(t, bf) do { _Pragma("unroll") for (int i_ = 0; i_ < 2; ++i_) GLDS(Kh + (size_t)KBASE(t) * D + koff[i_], 2 * SHM_V + (bf) * SHM_K + i_ * 8192 + ldsw); } while (0)
#define DMA_V(t, bf) do { _Pragma("unroll") for (int i_ = 0; i_ < 2; ++i_) GLDS(Vh + (size_t)KBASE(t) * D + voff[i_], (bf) * SHM_V + i_ * 8192 + ldsw); } while (0)
#define RESC(a) do { if (MODE != 2) { if (__any((a) < 1.f)) { if (hi == 0) al_l[r32] = (a); asm volatile("s_waitcnt lgkmcnt(0)" ::: "memory");              \
                     for (int d_ = 0; d_ < 4; ++d_) for (int r = 0; r < 16; ++r) o[d_][r] *= al_l[crow(r, hi)]; } } } while (0)
#define MASKT(P0_, P1_, t) do { const int kb_ = KBASE(t); \
        if (MODE == 0) { if (kb_ + KVBLK - 1 > qlo || kb_ <= qlo + QBLK - 1 - W) mask_tile(P0_, P1_, qm - kb_, (unsigned)W); } \
        if (MODE == 1) { if (kb_ + KVBLK - 1 > qlo) mask_tile(P0_, P1_, qm - kb_, 0x40000000u); if (use_sel) mask_all(P0_, P1_, ((selm >> (j_lo + (t))) & 1u) != 0u); } } while (0)
#define PART(P0_, P1_, mnX, alX, t) do { if (MODE == 2) { if (KBASE(t) + KVBLK - 1 <= qlo) decay_fast(P0_, P1_, qm - KBASE(t), lg, dc); else decay_apply(P0_, P1_, qm - KBASE(t), lg); alX = 1.f; } else partialSM(P0_, P1_, m_reg, mnX, alX); } while (0)
#define FINI(P0_, P1_, alY) do { if (MODE == 2) pack_p(P0_, P1_, pa0, pa1, pa2, pa3); else finishSM(P0_, P1_, alY, l_reg, pa0, pa1, pa2, pa3); } while (0)
    f32x16 pA0, pA1, pB0, pB1; float mnA = 0.f, mnB = 0.f, alA = 1.f, alB = 1.f; bf16x8 pa0, pa1, pa2, pa3;
    float dc[16];
    if (MODE == 2) {
#pragma unroll
        for (int r = 0; r < 16; ++r) dc[r] = __builtin_amdgcn_exp2f(-(float)((r & 3) + 8 * (r >> 2)) * lg); }
    __syncthreads();
    DMA_K(0, 0);
    VMW(); __syncthreads();
    if (NT > 1) DMA_K(1, 1);
    DMA_V(0, 0);
    SBAR(); qkt<0>(pA0, pA1, K_lds, r32, hi, qr);
    MASKT(pA0, pA1, 0); PART(pA0, pA1, mnA, alA, 0);
    VMW(); __syncthreads();
#define STEP(PX0, PX1, mnX, alX, PY0, PY1, alY, t, KB, VB) do {                                                      \
        if ((t) + 1 < NT) DMA_K((t) + 1, VB);                                                                        \
        DMA_V((t), KB);                                                                                              \
        SBAR(); qkt<KB>(PX0, PX1, K_lds, r32, hi, qr);                                                               \
        FINI(PY0, PY1, alY); SBAR();                                                                                 \
        pv_tile<VB>(o, vb0, pa0, pa1, pa2, pa3); MASKT(PX0, PX1, (t)); PART(PX0, PX1, mnX, alX, (t));               \
        RESC(alX);                                                                                                   \
        VMW(); __syncthreads(); } while (0)
    for (int t = 1; t + 1 < NT; t += 2) {
        STEP(pB0, pB1, mnB, alB, pA0, pA1, alA, t, 1, 0);
        STEP(pA0, pA1, mnA, alA, pB0, pB1, alB, t + 1, 0, 1);
    }
    const bool even = (NT & 1) == 0;
    if (even) { DMA_V(NT - 1, 1); SBAR(); qkt<1>(pB0, pB1, K_lds, r32, hi, qr); SBAR(); }
    FINI(pA0, pA1, alA); SBAR();
    pv_tile<0>(o, vb0, pa0, pa1, pa2, pa3);
    if (even) { MASKT(pB0, pB1, NT - 1); PART(pB0, pB1, mnB, alB, NT - 1); RESC(alB);
        VMW(); __syncthreads();
        FINI(pB0, pB1, alB); SBAR(); pv_tile<1>(o, vb0, pa0, pa1, pa2, pa3); }
#undef STEP
#undef FINI
#undef PART
#undef MASKT
#undef RESC
#undef DMA_V
#undef DMA_K
#undef GLDS
#undef KBASE
}
__device__ __forceinline__ void bcast_rows(float v, float* li_l, int r32, int hi, float (&rs)[16]) {
    if (hi == 0) li_l[r32] = v;
    asm volatile("s_waitcnt lgkmcnt(0)" ::: "memory");
#pragma unroll
    for (int r = 0; r < 16; ++r) rs[r] = li_l[crow(r, hi)];
    asm volatile("s_waitcnt lgkmcnt(0)" ::: "memory");
}
__device__ __forceinline__ void load_q(bf16x8 (&qr)[8], const bf16_t* Qw, int r32, int hi) {
#pragma unroll
    for (int d0 = 0; d0 < 8; ++d0) qr[d0] = *(const bf16x8*)(Qw + (size_t)r32 * D + d0 * 16 + hi * 8);
}
__device__ __forceinline__ void rowsum32(float (&s)[16]) {
#pragma unroll
    for (int off = 1; off < 32; off <<= 1)
#pragma unroll
        for (int r = 0; r < 16; ++r) s[r] += __shfl_xor(s[r], off);
}
}

__device__ __forceinline__ void compress_item(unsigned char* ws, const float* kg, const float* pek, const float* pev, char* lds, int item, const int wv) {
    const int tid = mk_tid(wv);
    const int wid = wv, lane = tid & 63, r32 = lane & 31, hi = lane >> 5;
    const int p = item >> 2, rg = item & 3;
    const int kv = p >> 3, bg = p & 7;
    const bf16_t* T = (const bf16_t*)(ws + (kv ? WS_VC : WS_KC)) + (size_t)bg * SEQ * 128;
    const bf16_t* W1T = (const bf16_t*)(ws + WS_CW1T) + (size_t)kv * 128 * 4096;
    const bf16_t* W2T = (const bf16_t*)(ws + WS_CW2T) + (size_t)kv * 128 * 128;
    float* red = (float*)lds;
    bf16_t* hid = (bf16_t*)(lds + 131072);
    f32x16 acc[4];
#pragma unroll
    for (int c = 0; c < 4; ++c) acc[c] = f32x16{};
    const int kbase = 512 * wid + 8 * hi;
    const bf16_t* ab = T + (size_t)(16 * (32 * rg + r32)) * 128 + kbase;
    const bf16_t* bb = W1T + (size_t)(wid * 32 * 4) * 512 + (size_t)lane * 8;
    const float* pe = (kv ? pev : pek) + kbase;
#pragma unroll 2
    for (int kh = 0; kh < 8; ++kh) {
        bf16x8 a[4], b[4][4];
#pragma unroll
        for (int ks = 0; ks < 4; ++ks) { a[ks] = *(const bf16x8*)(ab + 16 * (4 * kh + ks));
            { const f32x4 e0 = *(const f32x4*)(pe + 16 * (4 * kh + ks)), e1 = *(const f32x4*)(pe + 16 * (4 * kh + ks) + 4);
              const u32x4 w = *reinterpret_cast<const u32x4*>(&a[ks]); u32x4 o;
              o.x = cvtpk(bflo(w.x) + e0[0], bfhi(w.x) + e0[1]); o.y = cvtpk(bflo(w.y) + e0[2], bfhi(w.y) + e0[3]); o.z = cvtpk(bflo(w.z) + e1[0], bfhi(w.z) + e1[1]); o.w = cvtpk(bflo(w.w) + e1[2], bfhi(w.w) + e1[3]);
              a[ks] = *reinterpret_cast<const bf16x8*>(&o); }
#pragma unroll
            for (int cb = 0; cb < 4; ++cb) b[ks][cb] = *(const bf16x8*)(bb + (size_t)((4 * kh + ks) * 4 + cb) * 512); }
#pragma unroll
        for (int ks = 0; ks < 4; ++ks)
#pragma unroll
            for (int cb = 0; cb < 4; ++cb) acc[cb] = __builtin_amdgcn_mfma_f32_32x32x16_bf16(a[ks], b[ks][cb], acc[cb], 0, 0, 0);
    }
    __syncthreads();
#pragma unroll
    for (int cb = 0; cb < 4; ++cb)
#pragma unroll
        for (int r = 0; r < 16; ++r) red[(wid * 32 + att::crow(r, hi)) * 128 + cb * 32 + r32] = acc[cb][r];
    __syncthreads();
    {
        const int col = tid & 127;
#pragma unroll
        for (int i = 0; i < 8; ++i) { const int e = tid + 512 * i, row = e >> 7; float s = 0.f;
#pragma unroll
            for (int w = 0; w < 8; ++w) s += red[(w * 32 + row) * 128 + col];
            hid[row * 128 + col] = (bf16_t)f2bf(silu_f(s)); }
    }
    __syncthreads();
    if (wid < 4) {
        f32x16 a2 = f32x16{};
#pragma unroll
        for (int ks = 0; ks < 8; ++ks) { const bf16x8 a = *(const bf16x8*)(hid + r32 * 128 + 16 * ks + 8 * hi); const bf16x8 b = *(const bf16x8*)(W2T + (size_t)(wid * 32 + r32) * 128 + 16 * ks + 8 * hi);
            a2 = __builtin_amdgcn_mfma_f32_32x32x16_bf16(a, b, a2, 0, 0, 0); }
#pragma unroll
        for (int r = 0; r < 16; ++r) red[att::crow(r, hi) * 128 + wid * 32 + r32] = a2[r];
    }
    __syncthreads();
    bf16_t* OUT = (bf16_t*)(ws + (kv ? WS_VCMP : WS_KCMP)) + (size_t)bg * 128 * 128;
#pragma unroll
    for (int e = 0; e < 4; ++e) {
        const int row = wid + 8 * e, n = 32 * rg + row; float x1 = red[row * 128 + lane], x2 = red[row * 128 + 64 + lane];
        if (kv == 0) {
            const float rr = 1.0f / sqrtf(wave_sum(x1 * x1 + x2 * x2) * (1.0f / 128.0f) + EPS);
            const int pos = (n < 127) ? 16 * n + 31 : 0;
            const float y1 = x1 * rr * kg[lane], y2 = x2 * rr * kg[lane + 64];
            const float c = ((const float*)(ws + WS_COS))[pos * 64 + lane], s = ((const float*)(ws + WS_SIN))[pos * 64 + lane];
            x1 = y1 * c - y2 * s; x2 = y1 * s + y2 * c;
        }
        if (n >= 127) { x1 = 0.f; x2 = 0.f; }
        __hip_atomic_store(OUT + (size_t)n * 128 + lane, (bf16_t)f2bf(x1), __ATOMIC_RELAXED, __HIP_MEMORY_SCOPE_AGENT);
        __hip_atomic_store(OUT + (size_t)n * 128 + 64 + lane, (bf16_t)f2bf(x2), __ATOMIC_RELAXED, __HIP_MEMORY_SCOPE_AGENT);
    }
    asm volatile("s_waitcnt vmcnt(0)" ::: "memory");
    __syncthreads();
    if (tid == 0) __hip_atomic_fetch_add((unsigned*)(ws + WS_CTL) + 300, 1u, __ATOMIC_RELAXED, __HIP_MEMORY_SCOPE_AGENT);
}

__device__ __forceinline__ void stage_o(char* lds, int wid, const f32x16 (&o)[4], const float (&rs)[16], int r32, int hi) {
    bf16_t* stg = (bf16_t*)lds + wid * 4096;
    asm volatile("" : "+v"(r32), "+v"(hi));
#pragma unroll
    for (int r = 0; r < 16; ++r) { const int orow = att::crow(r, hi);
#pragma unroll
        for (int d0 = 0; d0 < 4; ++d0) { const float v = o[d0][r] * rs[r]; stg[orow * 128 + d0 * 32 + r32] = (bf16_t)(cvtpk(v, v) & 0xffffu); } }
    asm volatile("s_waitcnt lgkmcnt(0)" ::: "memory");
}
__device__ __forceinline__ u32x4 ldo(const char* lds, int wid, int i, int lane) { return *(const u32x4*)((const bf16_t*)lds + wid * 4096 + (i * 4 + (lane >> 4)) * 128 + (lane & 15) * 8); }
__device__ __forceinline__ void unpack8(const u32x4 w, float (&f)[8]) { f[0] = bflo(w.x); f[1] = bfhi(w.x); f[2] = bflo(w.y); f[3] = bfhi(w.y); f[4] = bflo(w.z); f[5] = bfhi(w.z); f[6] = bflo(w.w); f[7] = bfhi(w.w); }
__device__ __forceinline__ u32x4 pack8f(const float (&f)[8]) { u32x4 w; w.x = cvtpk(f[0], f[1]); w.y = cvtpk(f[2], f[3]); w.z = cvtpk(f[4], f[5]); w.w = cvtpk(f[6], f[7]); return w; }
__device__ __forceinline__ void copy_staged(const char* lds, int wid, int lane, bf16_t* dst, size_t stride) {
    asm volatile("" : "+v"(lane));
#pragma unroll
    for (int i = 0; i < 8; ++i) { const u32x4 w = ldo(lds, wid, i, lane); *(u32x4*)(dst + (size_t)(i * 4 + (lane >> 4)) * stride + (lane & 15) * 8) = w; }
}
__device__ __forceinline__ void copy_staged_wt(const char* lds, int wid, int lane, __amdgpu_buffer_rsrc_t rsrc, unsigned base_bytes, unsigned stride_bytes) {
    asm volatile("" : "+v"(lane));
#pragma unroll
    for (int i = 0; i < 8; ++i) { const u32x4 w = ldo(lds, wid, i, lane);
        __builtin_amdgcn_raw_buffer_store_b128(w, rsrc, (int)(base_bytes + (unsigned)(i * 4 + (lane >> 4)) * stride_bytes + (unsigned)(lane & 15) * 16u), 0, 16); }
}
__device__ __forceinline__ void nsa_unit(unsigned char* ws, char* lds, int bg, int tb, int part, const int wv) {
    using namespace att;
    const int tid = mk_tid(wv);
    const int wid = wv, lane = tid & 63, r32 = lane & 31, hi = lane >> 5;
    const int b = bg >> 1, g = bg & 1, P0 = tb * 64, rh = wid >> 1, half = wid & 1, hq = g * 4 + rh;
    const int qlo = P0 + 32 * half, tok = qlo + r32;
    float* wsf = (float*)(lds + LDS_WS) + wid * 64;
    bf16_t* SA = (bf16_t*)(ws + WS_NSCR) + (size_t)(bg * 32 + tb) * 65536;
    bf16_t* SB = SA + 32768;
    bf16x8 qr[8];
    load_q(qr, (const bf16_t*)(ws + WS_NQ) + ((size_t)(b * 8 + hq) * SEQ + qlo) * 128, r32, hi);
    const float* gates0 = (const float*)(ws + WS_GATES) + ((size_t)b * SEQ + qlo) * 24 + hq;
#define GATE(br) ({ int l_ = r32; asm volatile("" : "+v"(l_)); gates0[l_ * 24 + 8 * (br)]; })
    f32x16 o[4]; float rs[16];
    if (part != 2) {
        if (tid == 0) { const unsigned* ck = (const unsigned*)(ws + WS_CTL) + 300; unsigned sp_ = 0;
            while (__hip_atomic_load(ck, __ATOMIC_RELAXED, __HIP_MEMORY_SCOPE_AGENT) < 64u) { __builtin_amdgcn_s_sleep(4); if (++sp_ > (1u << 22)) break; }
            __builtin_amdgcn_fence(__ATOMIC_ACQUIRE, "agent"); asm volatile("s_waitcnt vmcnt(0)" ::: "memory"); }
        const bf16_t* Kc = (const bf16_t*)(ws + WS_KCMP) + (size_t)bg * 128 * 128; const bf16_t* Vc = (const bf16_t*)(ws + WS_VCMP) + (size_t)bg * 128 * 128;
        char* V_lds = lds; char* K_lds = lds + 2 * SHM_V;
        const int sr = tid >> 4, sc = (tid & 15) * 8, vst0 = v_st(sr, sc), vst1 = v_st(32 + sr, sc), kws = KSWZ(sr, sc * 2);
        const int vb0 = (int)(uintptr_t)V_lds + v_rd_base(lane);
        __syncthreads();
#pragma unroll
        for (int t = 0; t < 2; ++t) {
            const bf16x8 v0 = *(const bf16x8*)(Vc + (size_t)(64 * t + sr) * 128 + sc), v1 = *(const bf16x8*)(Vc + (size_t)(64 * t + 32 + sr) * 128 + sc);
            const bf16x8 k0 = *(const bf16x8*)(Kc + (size_t)(64 * t + sr) * 128 + sc), k1 = *(const bf16x8*)(Kc + (size_t)(64 * t + 32 + sr) * 128 + sc);
            *(bf16x8*)(V_lds + t * SHM_V + vst0) = v0; *(bf16x8*)(V_lds + t * SHM_V + vst1) = v1;
            *(bf16x8*)(K_lds + t * SHM_K + kws) = k0; *(bf16x8*)(K_lds + t * SHM_K + kws + 32 * 256) = k1;
        }
        __syncthreads();
        f32x16 pA0, pA1, pB0, pB1;
        qkt<0>(pA0, pA1, K_lds, r32, hi, qr); qkt<1>(pB0, pB1, K_lds, r32, hi, qr);
        int nvalid = (tok - 15) >> 4; nvalid = nvalid < 0 ? 0 : nvalid;
        const float NEG = -__builtin_inff();
        float mx = NEG;
#pragma unroll
        for (int r = 0; r < 16; ++r) { const int n = (r & 3) + 8 * (r >> 2) + 4 * hi;
            pA0[r] = (n < nvalid) ? pA0[r] : NEG; pA1[r] = (n + 32 < nvalid) ? pA1[r] : NEG; pB0[r] = (n + 64 < nvalid) ? pB0[r] : NEG; pB1[r] = (n + 96 < nvalid) ? pB1[r] : NEG;
            mx = fmaxf(fmaxf(mx, pA0[r]), fmaxf(pA1[r], fmaxf(pB0[r], pB1[r]))); }
        { auto rr = __builtin_amdgcn_permlane32_swap(__float_as_uint(mx), __float_as_uint(mx), false, false); mx = fmaxf(__uint_as_float(rr[0]), __uint_as_float(rr[1])); }
        const float mL = (mx == NEG) ? 0.f : -mx * C2; float ps = 0.f;
#pragma unroll
        for (int r = 0; r < 16; ++r) { pA0[r] = __builtin_amdgcn_exp2f(fmaf(pA0[r], C2, mL)); pA1[r] = __builtin_amdgcn_exp2f(fmaf(pA1[r], C2, mL));
            pB0[r] = __builtin_amdgcn_exp2f(fmaf(pB0[r], C2, mL)); pB1[r] = __builtin_amdgcn_exp2f(fmaf(pB1[r], C2, mL)); ps += (pA0[r] + pA1[r]) + (pB0[r] + pB1[r]); }
        { auto rr = __builtin_amdgcn_permlane32_swap(__float_as_uint(ps), __float_as_uint(ps), false, false); ps = __uint_as_float(rr[0]) + __uint_as_float(rr[1]); }
        const float inv = ps > 0.f ? 1.0f / ps : 0.f;
#pragma unroll
        for (int r = 0; r < 16; ++r) { pA0[r] *= inv; pA1[r] *= inv; pB0[r] *= inv; pB1[r] *= inv; }
        if (tb >= 16) {
            float* IMP = (float*)(lds + LDS_IMP) + (wid * 32 + r32) * 33;
#define IMPQ(P, q) do { _Pragma("unroll") for (int k = 0; k < 4; ++k) { \
                const float gs = (P[4 * k] + P[4 * k + 1]) + (P[4 * k + 2] + P[4 * k + 3]); const float last = P[4 * k + 3]; \
                auto rr = __builtin_amdgcn_permlane32_swap(__float_as_uint(last), __float_as_uint(last), false, false); \
                const float lp = hi ? __uint_as_float(rr[0]) : __uint_as_float(rr[1]);       \
                gsum[q * 4 + k] = gs; lpar[q * 4 + k] = lp; } } while (0)
            float gsum[16], lpar[16];
            IMPQ(pA0, 0); IMPQ(pA1, 1); IMPQ(pB0, 2); IMPQ(pB1, 3);
#undef IMPQ
#pragma unroll
            for (int i = 0; i < 16; ++i) {
                const float prev = hi ? lpar[i] : (i > 0 ? lpar[i - 1] : 0.f);
                IMP[2 * i + hi] = gsum[i] + prev;
            }
        }
        bf16x8 pa0, pa1, pa2, pa3;
#pragma unroll
        for (int d = 0; d < 4; ++d) o[d] = f32x16{};
        pack_p(pA0, pA1, pa0, pa1, pa2, pa3); SBAR(); pv_tile<0>(o, vb0, pa0, pa1, pa2, pa3);
        pack_p(pB0, pB1, pa0, pa1, pa2, pa3); SBAR(); pv_tile<1>(o, vb0, pa0, pa1, pa2, pa3);
        bcast_rows(GATE(0), wsf, r32, hi, rs);
        __syncthreads();
        stage_o(lds, wid, o, rs, r32, hi);
        copy_staged(lds, wid, lane, SA + (size_t)(wid * 32) * 128, 128);
        __syncthreads();
        if (tb >= 16) {
            float* IMPb = (float*)(lds + LDS_IMP); float* SC = (float*)(lds + LDS_SC); unsigned* SELM = (unsigned*)(lds + LDS_SELM);
#pragma unroll
            for (int e = 0; e < 4; ++e) { const int idx = tid + 512 * e, tk = idx >> 5, m = idx & 31;
                float s = 0.f;
#pragma unroll
                for (int r = 0; r < 4; ++r) s += IMPb[((2 * r + (tk >> 5)) * 32 + (tk & 31)) * 33 + m];
                const bool forced = (m == 0) || (m == tb) || (m == tb - 1);
                SC[tk * 33 + m] = forced ? 1e9f : (m <= tb ? s : -1e9f); }
            __syncthreads();
#pragma unroll
            for (int e = 0; e < 4; ++e) { const int idx = tid + 512 * e, tk = idx >> 5, m = idx & 31;
                const float v = SC[tk * 33 + m]; int rank = 0;
                for (int j = 0; j < 32; ++j) { const float u = SC[tk * 33 + j]; rank += (u > v || (u == v && j < m)) ? 1 : 0; }
                const unsigned long long bal = __ballot(rank < 16 && m <= tb);
                if ((lane & 31) == 0) SELM[tk] = hi ? (unsigned)(bal >> 32) : (unsigned)bal; }
            __syncthreads();
        }
    }
    if (part != 2) {
        const unsigned selm = (tb >= 16) ? ((const unsigned*)(lds + LDS_SELM))[32 * half + r32] : 0xffffffffu;
        float l_reg;
        attn_core<1>(o, l_reg, qr, (const bf16_t*)(ws + WS_KS) + (size_t)bg * SEQ * 128, (const bf16_t*)(ws + WS_VS) + (size_t)bg * SEQ * 128, 0, tb + 1, qlo, 0, selm, tb >= 16, 0.f, lds, wv);
        const int lane = mk_tid(wv) & 63, r32 = lane & 31, hi = lane >> 5;
        bcast_rows(GATE(1) / l_reg, wsf, r32, hi, rs);
        __syncthreads();
        stage_o(lds, wid, o, rs, r32, hi);
        if (part == 0) copy_staged(lds, wid, lane, SB + (size_t)(wid * 32) * 128, 128);
        else {
            asm volatile("s_waitcnt vmcnt(0)" ::: "memory");
            const __amdgpu_buffer_rsrc_t sar = __builtin_amdgcn_make_buffer_rsrc((void*)SA, 0, 65536, 0x00020000);
            int ln = lane; asm volatile("" : "+v"(ln));
#pragma unroll
            for (int i = 0; i < 8; ++i) { const int row = i * 4 + (ln >> 4), c = (ln & 15) * 8;
                float w[8], a[8]; unpack8(ldo(lds, wid, i, ln), w); unpack8(*(const u32x4*)(SA + (size_t)(wid * 32 + row) * 128 + c), a);
#pragma unroll
                for (int j = 0; j < 8; ++j) w[j] += a[j];
                __builtin_amdgcn_raw_buffer_store_b128(pack8f(w), sar, (int)(((wid * 32 + row) * 128 + c) * 2), 0, 16); }
        }
    }
    const bf16_t* sng = (const bf16_t*)(ws + WS_SNG) + ((size_t)b * SEQ + qlo) * 1024 + hq * 128;
    bf16_t* y = (bf16_t*)(ws + WS_Y0) + ((size_t)b * SEQ + qlo) * DM + 1024 + hq * 128;
    if (part != 1) {
        const int lowk = P0 - 511, j_lo = lowk > 0 ? lowk / 64 : 0;
        float l_reg;
        attn_core<0>(o, l_reg, qr, (const bf16_t*)(ws + WS_KW) + (size_t)bg * SEQ * 128, (const bf16_t*)(ws + WS_VW) + (size_t)bg * SEQ * 128, j_lo, tb + 1 - j_lo, qlo, 512, 0u, false, 0.f, lds, wv);
        const int lane = mk_tid(wv) & 63, r32 = lane & 31, hi = lane >> 5;
        bcast_rows(GATE(2) / l_reg, wsf, r32, hi, rs);
        __syncthreads();
        stage_o(lds, wid, o, rs, r32, hi);
        if (part == 0) {
            asm volatile("s_waitcnt vmcnt(0)" ::: "memory");
            int ln = lane; asm volatile("" : "+v"(ln));
#pragma unroll
            for (int i = 0; i < 8; ++i) { const int row = i * 4 + (ln >> 4), c = (ln & 15) * 8;
                float w[8], a[8], bq[8], gt[8];
                unpack8(ldo(lds, wid, i, ln), w); unpack8(*(const u32x4*)(SA + (size_t)(wid * 32 + row) * 128 + c), a); unpack8(*(const u32x4*)(SB + (size_t)(wid * 32 + row) * 128 + c), bq);
                unpack8(*(const u32x4*)(sng + (size_t)row * 1024 + c), gt);
#pragma unroll
                for (int j = 0; j < 8; ++j) w[j] = (w[j] + a[j] + bq[j]) * gt[j];
                *(u32x4*)(y + (size_t)row * DM + c) = pack8f(w); }
        } else {
            const __amdgpu_buffer_rsrc_t sbr = __builtin_amdgcn_make_buffer_rsrc((void*)SB, 0, 65536, 0x00020000);
            copy_staged_wt(lds, wid, lane, sbr, (unsigned)(wid * 32 * 128 * 2), 256u);
        }
    }
    if (part != 0) {
        unsigned* flag = (unsigned*)(lds + LDS_BYTES - 32);
        asm volatile("s_waitcnt vmcnt(0)" ::: "memory");
        __syncthreads();
        if (mk_tid(wv) == 0) {
            unsigned* cnt = (unsigned*)(ws + WS_CTL) + 768 + (bg * 32 + tb);
            const unsigned old = __hip_atomic_fetch_add(cnt, 1u, __ATOMIC_RELAXED, __HIP_MEMORY_SCOPE_AGENT);
            if (old == 1u) { __builtin_amdgcn_fence(__ATOMIC_ACQUIRE, "agent"); asm volatile("s_waitcnt vmcnt(0)" ::: "memory"); }
            *flag = old;
        }
        __syncthreads();
        if (*flag == 1u) {
            int ln = mk_tid(wv) & 63;
#pragma unroll
            for (int i = 0; i < 8; ++i) { const int row = i * 4 + (ln >> 4), c = (ln & 15) * 8;
                float a[8], bq[8], gt[8];
                unpack8(*(const u32x4*)(SA + (size_t)(wid * 32 + row) * 128 + c), a); unpack8(*(const u32x4*)(SB + (size_t)(wid * 32 + row) * 128 + c), bq);
                unpack8(*(const u32x4*)(sng + (size_t)row * 1024 + c), gt);
#pragma unroll
                for (int j = 0; j < 8; ++j) a[j] = (a[j] + bq[j]) * gt[j];
                *(u32x4*)(y + (size_t)row * DM + c) = pack8f(a); }
        }
    }
}
#undef GATE
__device__ __forceinline__ void kv_unit(unsigned char* ws, char* lds, int bh, int m, float lg, const int wv) {
    using namespace att;
    const int tid = mk_tid(wv);
    const int wid = wv, lane = tid & 63, r32 = lane & 31, hi = lane >> 5;
    const bf16_t* Kh = (const bf16_t*)(ws + WS_RK) + ((size_t)bh * SEQ + 256 * m) * 128; const bf16_t* Vh = (const bf16_t*)(ws + WS_RV) + ((size_t)bh * SEQ + 256 * m) * 128;
    const int sr = tid >> 4, sc = (tid & 15) * 8, vst0 = v_st(sr, sc), vst1 = v_st(32 + sr, sc);
    const int db = wid & 3, ep = wid >> 2;
    const int vbA = (int)(uintptr_t)lds + v_rd_base(lane) + db * 512, vbB = (int)(uintptr_t)lds + SHM_V + v_rd_base(lane) + ep * 1024;
    f32x16 acc0 = f32x16{}, acc1 = f32x16{};
#pragma unroll 1
    for (int t = 0; t < 4; ++t) {
        const bf16x8 v0 = *(const bf16x8*)(Vh + (size_t)(64 * t + sr) * 128 + sc), v1 = *(const bf16x8*)(Vh + (size_t)(64 * t + 32 + sr) * 128 + sc);
        const u32x4 k0 = *(const u32x4*)(Kh + (size_t)(64 * t + sr) * 128 + sc), k1 = *(const u32x4*)(Kh + (size_t)(64 * t + 32 + sr) * 128 + sc);
        const float w0 = __builtin_amdgcn_exp2f((float)(256 - (64 * t + sr)) * lg), w1 = __builtin_amdgcn_exp2f((float)(256 - (64 * t + 32 + sr)) * lg);
        u32x4 a, b2;
        a.x = cvtpk(bflo(k0.x) * w0, bfhi(k0.x) * w0); a.y = cvtpk(bflo(k0.y) * w0, bfhi(k0.y) * w0); a.z = cvtpk(bflo(k0.z) * w0, bfhi(k0.z) * w0); a.w = cvtpk(bflo(k0.w) * w0, bfhi(k0.w) * w0);
        b2.x = cvtpk(bflo(k1.x) * w1, bfhi(k1.x) * w1); b2.y = cvtpk(bflo(k1.y) * w1, bfhi(k1.y) * w1); b2.z = cvtpk(bflo(k1.z) * w1, bfhi(k1.z) * w1); b2.w = cvtpk(bflo(k1.w) * w1, bfhi(k1.w) * w1);
        __syncthreads();
        *(u32x4*)(lds + vst0) = a; *(u32x4*)(lds + vst1) = b2;
        *(bf16x8*)(lds + SHM_V + vst0) = v0; *(bf16x8*)(lds + SHM_V + vst1) = v1;
        __syncthreads();
#define TRRD(dst, base, off) asm volatile("ds_read_b64_tr_b16 %0, %1 offset:%2" : "=&v"(dst) : "v"(base), "i"(off) : "memory")
#pragma unroll
        for (int ks = 0; ks < 4; ++ks) { s16x4 al, ah, b0l, b0h, b1l, b1h;
            if (ks == 0) { TRRD(al, vbA, 0); TRRD(ah, vbA, 2048); TRRD(b0l, vbB, 0); TRRD(b0h, vbB, 2048); TRRD(b1l, vbB, 512); TRRD(b1h, vbB, 512 + 2048); }
            if (ks == 1) { TRRD(al, vbA, 4096); TRRD(ah, vbA, 4096 + 2048); TRRD(b0l, vbB, 4096); TRRD(b0h, vbB, 4096 + 2048); TRRD(b1l, vbB, 4096 + 512); TRRD(b1h, vbB, 4096 + 512 + 2048); }
            if (ks == 2) { TRRD(al, vbA, 8192); TRRD(ah, vbA, 8192 + 2048); TRRD(b0l, vbB, 8192); TRRD(b0h, vbB, 8192 + 2048); TRRD(b1l, vbB, 8192 + 512); TRRD(b1h, vbB, 8192 + 512 + 2048); }
            if (ks == 3) { TRRD(al, vbA, 12288); TRRD(ah, vbA, 12288 + 2048); TRRD(b0l, vbB, 12288); TRRD(b0h, vbB, 12288 + 2048); TRRD(b1l, vbB, 12288 + 512); TRRD(b1h, vbB, 12288 + 512 + 2048); }
            asm volatile("s_waitcnt lgkmcnt(0)" ::: "memory"); SBAR();
            const bf16x8 af = (bf16x8){al[0], al[1], al[2], al[3], ah[0], ah[1], ah[2], ah[3]};
            acc0 = __builtin_amdgcn_mfma_f32_32x32x16_bf16(af, (bf16x8){b0l[0], b0l[1], b0l[2], b0l[3], b0h[0], b0h[1], b0h[2], b0h[3]}, acc0, 0, 0, 0);
            acc1 = __builtin_amdgcn_mfma_f32_32x32x16_bf16(af, (bf16x8){b1l[0], b1l[1], b1l[2], b1l[3], b1h[0], b1h[1], b1h[2], b1h[3]}, acc1, 0, 0, 0); }
#undef TRRD
    }
    float* KV = (float*)(ws + WS_KVS) + (size_t)(bh * 7 + m) * 16384;
#pragma unroll
    for (int r = 0; r < 16; ++r) { const int d = 32 * db + crow(r, hi);
        __hip_atomic_store(KV + d * 128 + 32 * (2 * ep) + r32, acc0[r], __ATOMIC_RELAXED, __HIP_MEMORY_SCOPE_AGENT);
        __hip_atomic_store(KV + d * 128 + 32 * (2 * ep + 1) + r32, acc1[r], __ATOMIC_RELAXED, __HIP_MEMORY_SCOPE_AGENT); }
    asm volatile("s_waitcnt vmcnt(0)" ::: "memory");
    __syncthreads();
    if (tid == 0) __hip_atomic_fetch_add((unsigned*)(ws + WS_CTL) + 320 + bh, 1u, __ATOMIC_RELAXED, __HIP_MEMORY_SCOPE_AGENT);
}
__device__ __forceinline__ void ret_unit(unsigned char* ws, char* lds, int bh, int qb, float lg, const int wv) {
    using namespace att;
    const int wid = wv;
    const int b = bh >> 3, h = bh & 7, qlo = qb * 256 + wid * 32;
    bf16x8 qr[8];
    { const int lane = mk_tid(wv) & 63; load_q(qr, (const bf16_t*)(ws + WS_RQ) + ((size_t)bh * SEQ + qlo) * 128, lane & 31, lane >> 5); }
    f32x16 o[4]; float l_reg;
    if (qb > 0 && mk_tid(wv) == 0) { const unsigned* ck = (const unsigned*)(ws + WS_CTL) + 320 + bh; unsigned sp_ = 0;
        while (__hip_atomic_load(ck, __ATOMIC_RELAXED, __HIP_MEMORY_SCOPE_AGENT) < 7u) { __builtin_amdgcn_s_sleep(4); if (++sp_ > (1u << 22)) break; }
        __builtin_amdgcn_fence(__ATOMIC_ACQUIRE, "agent"); }
    attn_core<2>(o, l_reg, qr, (const bf16_t*)(ws + WS_RK) + (size_t)bh * SEQ * 128, (const bf16_t*)(ws + WS_RV) + (size_t)bh * SEQ * 128, 4 * qb, 4, qlo, 0, 0u, false, lg, lds, wv);
    const int tid = mk_tid(wv);
    const int lane = tid & 63, r32 = lane & 31, hi = lane >> 5;
    if (qb > 0) {
        __syncthreads();
        {
            const int sr = tid >> 4, sc = (tid & 15) * 8, vst0 = v_st(sr, sc), vst1 = v_st(32 + sr, sc);
            const float* KV = (const float*)(ws + WS_KVS) + (size_t)(bh * 7) * 16384 + sc;
            f32x4 s[4][2];
#pragma unroll
            for (int q = 0; q < 4; ++q) { s[q][0] = f32x4{0.f, 0.f, 0.f, 0.f}; s[q][1] = f32x4{0.f, 0.f, 0.f, 0.f}; }
            const float g256 = __builtin_amdgcn_exp2f(256.0f * lg);
            for (int mm = 0; mm < qb; ++mm) {
                const float* p = KV + (size_t)mm * 16384;
#pragma unroll
                for (int q = 0; q < 4; ++q) { const int d = 32 * q + sr;
                    s[q][0] = s[q][0] * g256 + *(const f32x4*)(p + d * 128); s[q][1] = s[q][1] * g256 + *(const f32x4*)(p + d * 128 + 4); }
            }
#pragma unroll
            for (int q = 0; q < 4; ++q) { u32x4 w; w.x = cvtpk(s[q][0][0], s[q][0][1]); w.y = cvtpk(s[q][0][2], s[q][0][3]); w.z = cvtpk(s[q][1][0], s[q][1][1]); w.w = cvtpk(s[q][1][2], s[q][1][3]);
                *(u32x4*)(lds + (q >> 1) * SHM_V + ((q & 1) ? vst1 : vst0)) = w; }
        }
        __syncthreads();
        const float f = __builtin_amdgcn_exp2f((float)(wid * 32 + r32) * lg);
        bf16x8 qs[8];
#pragma unroll
        for (int d0 = 0; d0 < 8; ++d0) { const u32x4 w = *reinterpret_cast<const u32x4*>(&qr[d0]); u32x4 x;
            x.x = cvtpk(bflo(w.x) * f, bfhi(w.x) * f); x.y = cvtpk(bflo(w.y) * f, bfhi(w.y) * f); x.z = cvtpk(bflo(w.z) * f, bfhi(w.z) * f); x.w = cvtpk(bflo(w.w) * f, bfhi(w.w) * f);
            qs[d0] = *reinterpret_cast<const bf16x8*>(&x); }
        const int vb0 = (int)(uintptr_t)lds + v_rd_base(lane);
        pv_tile<0>(o, vb0, qs[0], qs[1], qs[2], qs[3]);
        pv_tile<1>(o, vb0, qs[4], qs[5], qs[6], qs[7]);
    }
    float rs[16];
#pragma unroll
    for (int r = 0; r < 16; ++r) rs[r] = 1.0f;
    __syncthreads();
    stage_o(lds, wid, o, rs, r32, hi);
    const bf16_t* srg = (const bf16_t*)(ws + WS_SRG) + ((size_t)b * SEQ + qlo) * 1024 + h * 128;
    bf16_t* y = (bf16_t*)(ws + WS_Y0) + ((size_t)b * SEQ + qlo) * DM + h * 128;
    int ln = lane; asm volatile("" : "+v"(ln));
#pragma unroll
    for (int i = 0; i < 8; ++i) { const int row = i * 4 + (ln >> 4), c = (ln & 15) * 8;
        float w[8], gt[8]; unpack8(ldo(lds, wid, i, ln), w); unpack8(*(const u32x4*)(srg + (size_t)row * 1024 + c), gt);
        float s = 0.f;
#pragma unroll
        for (int j = 0; j < 8; ++j) s += w[j] * w[j];
        s += __shfl_xor(s, 1); s += __shfl_xor(s, 2); s += __shfl_xor(s, 4); s += __shfl_xor(s, 8);
        const float rr = 1.0f / sqrtf(s * (1.0f / 128.0f) + EPS);
#pragma unroll
        for (int j = 0; j < 8; ++j) w[j] = w[j] * rr * gt[j];
        *(u32x4*)(y + (size_t)row * DM + c) = pack8f(w); }
}
namespace attw {
using namespace att;
constexpr int VT = 32768, KOFF = 65536, QOFF = 98304;
template <int VB>
__device__ __forceinline__ void pv_wide(f32x16* o, int vb0, bf16x8 pa0, bf16x8 pa1, bf16x8 pa2, bf16x8 pa3) {
#define TRRD(dst, off) asm volatile("ds_read_b64_tr_b16 %0, %1 offset:%2" : "=&v"(dst) : "v"(vb0), "i"(off) : "memory")
#define PV_LD(S, d0) do { constexpr int b_ = VB * VT + ((d0) >> 2) * 16384 + v_rd_off((d0) & 3, 0, 0); \
        TRRD(S##l0, b_); TRRD(S##h0, b_ + 2048); TRRD(S##l1, b_ + 4096); TRRD(S##h1, b_ + 6144); TRRD(S##l2, b_ + 8192); TRRD(S##h2, b_ + 10240); TRRD(S##l3, b_ + 12288); TRRD(S##h3, b_ + 14336); } while (0)
#define PV_MM(S, d0) do { \
        o[d0] = __builtin_amdgcn_mfma_f32_32x32x16_bf16(pa0, (bf16x8){S##l0[0], S##l0[1], S##l0[2], S##l0[3], S##h0[0], S##h0[1], S##h0[2], S##h0[3]}, o[d0], 0, 0, 0);   \
        o[d0] = __builtin_amdgcn_mfma_f32_32x32x16_bf16(pa1, (bf16x8){S##l1[0], S##l1[1], S##l1[2], S##l1[3], S##h1[0], S##h1[1], S##h1[2], S##h1[3]}, o[d0], 0, 0, 0);   \
        o[d0] = __builtin_amdgcn_mfma_f32_32x32x16_bf16(pa2, (bf16x8){S##l2[0], S##l2[1], S##l2[2], S##l2[3], S##h2[0], S##h2[1], S##h2[2], S##h2[3]}, o[d0], 0, 0, 0);   \
        o[d0] = __builtin_amdgcn_mfma_f32_32x32x16_bf16(pa3, (bf16x8){S##l3[0], S##l3[1], S##l3[2], S##l3[3], S##h3[0], S##h3[1], S##h3[2], S##h3[3]}, o[d0], 0, 0, 0); } while (0)
#define PV_STEP(Scur, Snext, d0) do { PV_LD(Snext, (d0) + 1); asm volatile("s_waitcnt lgkmcnt(8)" ::: "memory"); SBAR(); PV_MM(Scur, d0); SBAR(); } while (0)
    s16x4 Al0, Al1, Al2, Al3, Ah0, Ah1, Ah2, Ah3, Bl0, Bl1, Bl2, Bl3, Bh0, Bh1, Bh2, Bh3;
    PV_LD(A, 0);
    PV_STEP(A, B, 0); PV_STEP(B, A, 1); PV_STEP(A, B, 2); PV_STEP(B, A, 3); PV_STEP(A, B, 4); PV_STEP(B, A, 5); PV_STEP(A, B, 6);
    asm volatile("s_waitcnt lgkmcnt(0)" ::: "memory"); SBAR(); PV_MM(B, 7);
#undef PV_STEP
#undef PV_MM
#undef PV_LD
#undef TRRD
}
template <int KB>
__device__ __forceinline__ void qkt_q(f32x16& p0, f32x16& p1, const int (&ka)[4], const int (&qa)[4]) {
#define RD16(dst, addr, off) asm volatile("ds_read_b128 %0, %1 offset:%2" : "=&v"(dst) : "v"(addr), "i"(off) : "memory")
#define QK_LD(S, d0) do { RD16(S##q, qa[(d0) & 3], ((d0) >> 2) * 128); RD16(S##0, ka[(d0) & 3], KB * SHM_K + ((d0) >> 2) * 128); RD16(S##1, ka[(d0) & 3], KB * SHM_K + ((d0) >> 2) * 128 + 32 * 256); } while (0)
#define QK_MM(S) do { p0 = __builtin_amdgcn_mfma_f32_32x32x16_bf16(*reinterpret_cast<bf16x8*>(&S##0), *reinterpret_cast<bf16x8*>(&S##q), p0, 0, 0, 0); \
                      p1 = __builtin_amdgcn_mfma_f32_32x32x16_bf16(*reinterpret_cast<bf16x8*>(&S##1), *reinterpret_cast<bf16x8*>(&S##q), p1, 0, 0, 0); } while (0)
#define QK_STEP(Scur, Snext2, d0) do { QK_LD(Snext2, (d0) + 2); asm volatile("s_waitcnt lgkmcnt(6)" ::: "memory"); SBAR(); QK_MM(Scur); SBAR(); } while (0)
    u32x4 Aq, A0, A1, Bq, B0, B1, Cq, C0, C1;
    p0 = f32x16{}; p1 = f32x16{};
    QK_LD(A, 0); QK_LD(B, 1);
    QK_STEP(A, C, 0); QK_STEP(B, A, 1); QK_STEP(C, B, 2); QK_STEP(A, C, 3); QK_STEP(B, A, 4); QK_STEP(C, B, 5);
    asm volatile("s_waitcnt lgkmcnt(3)" ::: "memory"); SBAR(); QK_MM(A); SBAR();
    asm volatile("s_waitcnt lgkmcnt(0)" ::: "memory"); SBAR(); QK_MM(B);
#undef QK_STEP
#undef QK_MM
#undef QK_LD
#undef RD16
}
__device__ __forceinline__ void attn_wide(f32x16 (&o)[8], float& l_reg, const bf16_t* Qw, const bf16_t* __restrict__ Kh, const bf16_t* __restrict__ Vlo, const bf16_t* __restrict__ Vhi,
                                          int NT, int qlo, char* lds, LAS unsigned char* lds3, const int wv, const int var = 0) {
    const int tid = mk_tid(wv);
    const int wid = wv, lane = tid & 63, r32 = lane & 31, hi = lane >> 5;
    char* V_lds = lds; char* K_lds = lds + KOFF; char* Qw_lds = lds + QOFF + wid * 8192;
    float m_reg = -1e30f; l_reg = 0.f;
#pragma unroll
    for (int d = 0; d < 8; ++d) o[d] = f32x16{};
    const int vb0 = (int)(uintptr_t)V_lds + v_rd_base(lane);
    const int qm = qlo + r32 - 4 * hi;
    int koff[2], voff[2];
#pragma unroll
    for (int i = 0; i < 2; ++i) { const int ob = i * 8192 + wid * 1024 + lane * 16;
        const int row = ob >> 8, ch = ((ob >> 4) & 15) ^ (row & 7); koff[i] = row * D + ch * 8;
        const int st = ob >> 9, kk = (st >> 2) * 8 + ((ob & 511) >> 6), cc = (st & 3) * 32 + ((ob & 63) >> 1);
        const int key = (kk & ~0xC) | ((kk & 4) << 1) | ((kk & 8) >> 1); voff[i] = key * D + cc; }
    const unsigned ldsw = (unsigned)wid * 1024u;
    int ka[4], qa[4];
#pragma unroll
    for (int dd = 0; dd < 4; ++dd) { const int o_ = KSWZ(r32, (dd * 16 + hi * 8) * 2); ka[dd] = (int)(uintptr_t)K_lds + o_; qa[dd] = (int)(uintptr_t)Qw_lds + o_; }
#define GLDS(src, dstoff) __builtin_amdgcn_global_load_lds((const unsigned*)(src), (LAS unsigned*)(lds3 + (dstoff)), 16, 0, 0)
#define DMA_TILE(k0, bf) do { _Pragma("unroll") for (int i_ = 0; i_ < 2; ++i_) { \
        GLDS(Vlo + (size_t)(k0) * D + voff[i_], (bf) * VT + i_ * 8192 + ldsw); GLDS(Vhi + (size_t)(k0) * D + voff[i_], (bf) * VT + 16384 + i_ * 8192 + ldsw); \
        GLDS(Kh + (size_t)(k0) * D + koff[i_], KOFF + (bf) * SHM_K + i_ * 8192 + ldsw); } } while (0)
#define STEPW(t, B) do { f32x16 p0, p1; float mn, al; bf16x8 pa0, pa1, pa2, pa3; const int kb_ = (t) * KVBLK; \
        if ((t) + 1 < NT && !(var & 1)) DMA_TILE(((t) + 1) * KVBLK, (B) ^ 1); \
        SBAR(); if (!(var & 8)) qkt_q<B>(p0, p1, ka, qa); else { p0 = f32x16{}; p1 = f32x16{}; } \
        if (!(var & 2)) { \
        if (kb_ + KVBLK - 1 > qlo) mask_tile(p0, p1, qm - kb_, 0x40000000u); \
        partialSM(p0, p1, m_reg, mn, al); \
        if (__any(al < 1.f)) { for (int r = 0; r < 16; ++r) { const float f_ = __shfl(al, crow(r, hi)); for (int d_ = 0; d_ < 8; ++d_) o[d_][r] *= f_; } } \
        finishSM(p0, p1, al, l_reg, pa0, pa1, pa2, pa3); } else pack_p(p0, p1, pa0, pa1, pa2, pa3); SBAR(); \
        if (!(var & 4)) pv_wide<B>(o, vb0, pa0, pa1, pa2, pa3); \
        VMW(); __syncthreads(); } while (0)
    __syncthreads();
    DMA_TILE(0, 0);
    {
        bf16x8 qv[8];
#pragma unroll
        for (int i = 0; i < 8; ++i) { const int j = lane + 64 * i; qv[i] = *(const bf16x8*)(Qw + (size_t)(j >> 4) * D + (j & 15) * 8); }
#pragma unroll
        for (int i = 0; i < 8; ++i) { const int j = lane + 64 * i; *(bf16x8*)(Qw_lds + KSWZ(j >> 4, (j & 15) * 16)) = qv[i]; }
    }
    VMW(); __syncthreads();
    for (int t = 0; t < NT; t += 2) { STEPW(t, 0); STEPW(t + 1, 1); }
#undef STEPW
#undef DMA_TILE
#undef GLDS
}
}
__device__ __forceinline__ void diff_unit(unsigned char* ws, unsigned char* od1b  , char* lds, int b, int h, int c, int qb, float lam, const bool fin, const int wv, const int var = 0) {
    using namespace att;
    const int wid = wv;
    const int qlo = qb * 256 + wid * 32;
    if (var & 16) return;
    const size_t hd = (size_t)(b * 16 + h * 2 + c) * SEQ;
    f32x16 o[8]; float rs[16]; float l_reg;
    attw::attn_wide(o, l_reg, (const bf16_t*)(ws + WS_Q1) + (hd + qlo) * 128, (const bf16_t*)(ws + WS_K1) + hd * 128, (const bf16_t*)(ws + WS_V1) + (size_t)(b * 16 + h * 2) * SEQ * 128, (const bf16_t*)(ws + WS_V1) + (size_t)(b * 16 + h * 2 + 1) * SEQ * 128,
                    4 * (qb + 1), qlo, lds, (LAS unsigned char*)lds, wv, var);
    const int tid = mk_tid(wv);
    const int lane = tid & 63, r32 = lane & 31, hi = lane >> 5;
    { const float il = 1.0f / l_reg;
#pragma unroll
      for (int r = 0; r < 16; ++r) rs[r] = __shfl(il, crow(r, hi)); }
    if (var & 32) { if (o[0][0] == 12345.f && l_reg == 777.f) *(float*)(ws + WS_CTL + 4096) = 1.f; return; }
    unsigned* cnt = (unsigned*)(ws + WS_CTL) + 512 + ((b * 8 + h) * 8 + qb);
    f32x16 (&olo)[4] = *reinterpret_cast<f32x16 (*)[4]>(&o[0]); f32x16 (&ohi)[4] = *reinterpret_cast<f32x16 (*)[4]>(&o[4]);
    if (!fin) {
        const __amdgpu_buffer_rsrc_t odr = __builtin_amdgcn_make_buffer_rsrc((void*)(c ? od1b : ws + WS_OD), 0, 32 << 20, 0x00020000);
        const unsigned odb = (unsigned)((((size_t)b * SEQ + qlo) * DM + h * 256) * 2);
        stage_o(lds, wid, olo, rs, r32, hi); copy_staged_wt(lds, wid, lane, odr, odb, DM * 2);
        stage_o(lds, wid, ohi, rs, r32, hi); copy_staged_wt(lds, wid, lane, odr, odb + 256, DM * 2);
        asm volatile("s_waitcnt vmcnt(0)" ::: "memory");
        __syncthreads();
        if (tid == 0) __hip_atomic_fetch_add(cnt, 1u, __ATOMIC_RELAXED, __HIP_MEMORY_SCOPE_AGENT);
    } else {
        stage_o(lds, wid, olo, rs, r32, hi); stage_o(lds + 65536, wid, ohi, rs, r32, hi);
        int ln = lane; asm volatile("" : "+v"(ln));
        const size_t e0 = ((size_t)b * SEQ + qlo + (ln >> 4)) * DM + h * 256 + (ln & 15) * 8;
        const bf16_t* sg = (const bf16_t*)(ws + WS_SG1) + e0; const bf16_t* rem = (const bf16_t*)(c ? ws + WS_OD : od1b) + e0; bf16_t* y = (bf16_t*)(ws + WS_Y1) + e0;
        const float cl = c ? -lam : 1.0f, cr = c ? 1.0f : -lam;
        u32x4 g0[8], g1[8], q0[8], q1[8];
#pragma unroll
        for (int i = 0; i < 8; ++i) { g0[i] = *(const u32x4*)(sg + (size_t)(i * 4) * DM); g1[i] = *(const u32x4*)(sg + (size_t)(i * 4) * DM + 128); }
        if (tid == 0) { asm volatile("buffer_inv sc1" ::: "memory");
                        while (__hip_atomic_load(cnt, __ATOMIC_RELAXED, __HIP_MEMORY_SCOPE_AGENT) < 1u) __builtin_amdgcn_s_sleep(2);
                        asm volatile("s_waitcnt vmcnt(0)" ::: "memory"); }
        __syncthreads();
        if (!(var & 64)) {
#pragma unroll
        for (int i = 0; i < 8; ++i) { q0[i] = *(const u32x4*)(rem + (size_t)(i * 4) * DM); q1[i] = *(const u32x4*)(rem + (size_t)(i * 4) * DM + 128); }
#pragma unroll
        for (int i = 0; i < 8; ++i) {
            float L0[8], L1[8], R0[8], R1[8], G0[8], G1[8];
            unpack8(ldo(lds, wid, i, ln), L0); unpack8(ldo(lds + 65536, wid, i, ln), L1); unpack8(q0[i], R0); unpack8(q1[i], R1); unpack8(g0[i], G0); unpack8(g1[i], G1);
            float s = 0.f;
#pragma unroll
            for (int j = 0; j < 8; ++j) { L0[j] = cl * L0[j] + cr * R0[j]; L1[j] = cl * L1[j] + cr * R1[j]; s += L0[j] * L0[j] + L1[j] * L1[j]; }
            s += __shfl_xor(s, 1); s += __shfl_xor(s, 2); s += __shfl_xor(s, 4); s += __shfl_xor(s, 8);
            const float sc = (1.0f - LAMBDA_INIT) / sqrtf(s * (1.0f / 256.0f) + EPS);
#pragma unroll
            for (int j = 0; j < 8; ++j) { L0[j] = L0[j] * sc * G0[j]; L1[j] = L1[j] * sc * G1[j]; }
            *(u32x4*)(y + (size_t)(i * 4) * DM) = pack8f(L0); *(u32x4*)(y + (size_t)(i * 4) * DM + 128) = pack8f(L1); }
        }
    }
}

constexpr int NSA_SPLIT_TB = 16;
#ifndef CONV_EVERY
#define CONV_EVERY 3
#endif
constexpr int CONV_IN_P1 = 64;
constexpr int NQITEMS = 64 + 224 + 8 * NSA_SPLIT_TB + 2 * 8 * (32 - NSA_SPLIT_TB) + (NCONV - CONV_IN_P1) + 256;
struct ItemTable { unsigned short v[NQITEMS]; };
constexpr int nsa_cost(int tb) { return 10 * (4 + (tb + 1) + ((tb + 1) < 9 ? (tb + 1) : 9)); }
constexpr int nsaA_cost(int tb) { return 10 * (4 + (tb + 1)) + 5; }
constexpr int nsaB_cost(int tb) { return 10 * (1 + ((tb + 1) < 9 ? (tb + 1) : 9)) + 3; }
constexpr ItemTable make_items() {
    unsigned short w[NQITEMS] = {}; int m_ = 0;
    for (int m = 0; m < 7; ++m) for (int bh = 0; bh < 32; ++bh) w[m_++] = (unsigned short)(0x4000 | (bh << 3) | m);
    for (int tb = 31; tb >= NSA_SPLIT_TB; --tb) for (int bg = 0; bg < 8; ++bg) w[m_++] = (unsigned short)((2 << 8) | (bg << 5) | tb);
    for (int c = 600; c >= 0; --c)
        for (int tb = 31; tb >= 0; --tb) {
            if (tb < NSA_SPLIT_TB) { if (nsa_cost(tb) == c) for (int bg = 0; bg < 8; ++bg) w[m_++] = (unsigned short)((bg << 5) | tb); }
            else { if (nsaA_cost(tb) == c) for (int bg = 0; bg < 8; ++bg) w[m_++] = (unsigned short)((1 << 8) | (bg << 5) | tb); }
        }
    ItemTable t{}; int n = 0, cv = CONV_IN_P1;
    for (int it = 0; it < 64; ++it) t.v[n++] = (unsigned short)(0x1000 | it);
    for (int i = 0; i < m_; ++i) { t.v[n++] = w[i]; if ((i % CONV_EVERY) == CONV_EVERY - 1 && cv < NCONV) t.v[n++] = (unsigned short)(0x2000 | cv++); }
    while (cv < NCONV) t.v[n++] = (unsigned short)(0x2000 | cv++);
    for (int qb = 7; qb >= 0; --qb) for (int bh = 0; bh < 32; ++bh) t.v[n++] = (unsigned short)(0x8000 | (bh << 3) | qb);
    return t;
}
__device__ const ItemTable P3_ITEMS = make_items();
constexpr double log2_1m(double x) { double s = 0, p = x; for (int n = 1; n <= 12; ++n) { s += p / n; p *= x; } return -s * 1.4426950408889634074; }
constexpr double pow2neg(int e) { double v = 1; for (int i = 0; i < e; ++i) v *= 0.5; return v; }


#define XB_TMO      128
#define XB_XCNT(j)  (256  + 64 * (j))
#define XB_XSUB(j)  (1280 + 64 * (j))
#define XB_XGEN(j)  (2304 + 64 * (j))
#define XB_TOP      3328
#define XB_TOPGEN   3392
#define XB_SPIN_CAP (1u << 18)
__device__ __forceinline__ unsigned xb_ld(unsigned* p)              { return __hip_atomic_load(p, __ATOMIC_RELAXED, __HIP_MEMORY_SCOPE_AGENT); }
__device__ __forceinline__ unsigned xb_add(unsigned* p, unsigned v) { return __hip_atomic_fetch_add(p, v, __ATOMIC_RELAXED, __HIP_MEMORY_SCOPE_AGENT); }
__device__ __forceinline__ unsigned xb_xcc_id() { return (unsigned)__builtin_amdgcn_s_getreg((3 << 11) | 20) & 0xFu; }
#define XB_SPIN(cond, bar) do { unsigned _sp = 0; while (cond) { __builtin_amdgcn_s_sleep(1); \
    if ((++_sp & 255u) == 0u) { if (xb_ld(&(bar)[XB_TMO])) break; if (_sp > XB_SPIN_CAP) { atomicAdd(&(bar)[XB_TMO], 1u); break; } } } } while (0)
__device__ __forceinline__ void xcd_barrier(unsigned* bar, unsigned x, unsigned nloc, unsigned nx, bool leader) {
    asm volatile("s_waitcnt vmcnt(0)" ::: "memory");
    __syncthreads();
    if (leader) {
        __builtin_amdgcn_s_waitcnt(0);
        const unsigned old = xb_add(&bar[XB_XSUB(x)], 1u);
        const unsigned gen = old / nloc;
        if (old + 1u == (gen + 1u) * nloc) {
            __builtin_amdgcn_fence(__ATOMIC_RELEASE, "agent");
            asm volatile("s_waitcnt vmcnt(0)" ::: "memory");
            const unsigned og = xb_add(&bar[XB_TOP], 1u);
            const unsigned tg = og / nx;
            if (og + 1u == (tg + 1u) * nx) xb_add(&bar[XB_TOPGEN], 1u);
            else XB_SPIN(xb_ld(&bar[XB_TOPGEN]) == tg, bar);
            __builtin_amdgcn_fence(__ATOMIC_ACQUIRE, "agent");
            xb_add(&bar[XB_XGEN(x)], 1u);
            asm volatile("s_waitcnt vmcnt(0)" ::: "memory");
        } else {
            XB_SPIN(xb_ld(&bar[XB_XGEN(x)]) == gen, bar);
            __builtin_amdgcn_fence(__ATOMIC_ACQUIRE, "agent");
            asm volatile("s_waitcnt vmcnt(0)" ::: "memory");
        }
    }
    __syncthreads();
}
#ifndef SEAM_EARLY_INV
#define SEAM_EARLY_INV 1
#endif
__device__ __forceinline__ void xcd_barrier_seam(unsigned* bar, unsigned x, unsigned nloc, unsigned nx, bool leader, unsigned k, unsigned long long* pw = nullptr) {
    asm volatile("s_waitcnt vmcnt(0)" ::: "memory");
    __syncthreads();
    if (leader) {
        const unsigned long long t0_ = pw ? __builtin_amdgcn_s_memtime() : 0ull;
        __builtin_amdgcn_s_waitcnt(0);
        const unsigned old = xb_add(&bar[XB_XSUB(x)], 1u);
        if (old + 1u == (k + 1u) * nloc) {
            __builtin_amdgcn_fence(__ATOMIC_RELEASE, "agent");
            asm volatile("s_waitcnt vmcnt(0)" ::: "memory");
            (void)xb_add(&bar[XB_TOP], 1u);
        }
        const unsigned tgt = (k + 1u) * nx;
#if SEAM_EARLY_INV
        asm volatile("buffer_inv sc1" ::: "memory");
        XB_SPIN(xb_ld(&bar[XB_TOP]) < tgt, bar);
        asm volatile("s_waitcnt vmcnt(0)" ::: "memory");
#else
        XB_SPIN(xb_ld(&bar[XB_TOP]) < tgt, bar);
        __builtin_amdgcn_fence(__ATOMIC_ACQUIRE, "agent");
        asm volatile("s_waitcnt vmcnt(0)" ::: "memory");
#endif
        if (pw) pw[k] = __builtin_amdgcn_s_memtime() - t0_;
    }
    __syncthreads();
}
__device__ __forceinline__ void pair_barrier(unsigned* sub, unsigned* top, unsigned nloc, unsigned nx, unsigned* bar, bool leader) {
    asm volatile("s_waitcnt vmcnt(0)" ::: "memory");
    __syncthreads();
    if (leader) {
        __builtin_amdgcn_s_waitcnt(0);
        const unsigned old = xb_add(sub, 1u);
        if (old + 1u == nloc) {
            __builtin_amdgcn_fence(__ATOMIC_RELEASE, "agent");
            asm volatile("s_waitcnt vmcnt(0)" ::: "memory");
            (void)xb_add(top, 1u);
        }
        asm volatile("buffer_inv sc1" ::: "memory");
        XB_SPIN(xb_ld(top) < nx, bar);
        asm volatile("s_waitcnt vmcnt(0)" ::: "memory");
    }
    __syncthreads();
}
#ifndef G_ALIGN_BIG
#define G_ALIGN_BIG true
#endif
#ifndef G_SP2_BIG
#define G_SP2_BIG true
#endif
#ifndef G_ALIGN_ONE
#define G_ALIGN_ONE true
#endif
#ifndef G_SP2_ONE
#define G_SP2_ONE true
#endif
struct Args { const float* in[21]; float* out; unsigned char* ws; int ph_lo, ph_hi;
#ifdef PROBE_VAR
    int variant;
#endif
};
#ifdef PROBE_VAR
#define PVAR (args.variant)
#else
#define PVAR 0
#endif
constexpr int NPHASE = 7;

__global__ void __launch_bounds__(512, 2) mega_fwd(Args args) {
    extern __shared__ __attribute__((aligned(16))) unsigned char lds_raw[];
    LAS unsigned char* lds3 = (LAS unsigned char*)lds_raw;
    char* lds = (char*)lds_raw;
    cg::grid_group grid = cg::this_grid();
    unsigned char* ws = args.ws;
    const int wv = __builtin_amdgcn_readfirstlane(threadIdx.x >> 6);
#define FRESH_TID() const int tid = mk_tid(wv); const int lane = tid & 63, wave = wv; (void)lane; (void)wave
    const int G = gridDim.x, bx = blockIdx.x;
    const int vcu = (G % 8 == 0) ? (bx % 8) * (G / 8) + bx / 8 : bx;
    const int lo = args.ph_lo, hi_ph = args.ph_hi;
    const float* cosT = (const float*)(ws + WS_COS); const float* sinT = (const float*)(ws + WS_SIN);
#ifndef PHASE_MASK
#define PHASE_MASK 0x7f
#endif
#define IN(k) (((PHASE_MASK >> (k)) & 1) && lo <= (k) && (k) < hi_ph)
    unsigned nbar = 0;
#define BARRIER_ONLY() do { ++nbar; \
        asm volatile("s_waitcnt vmcnt(0)" ::: "memory"); __syncthreads(); \
        if (mk_tid(wv) == 0) { unsigned* ctr_ = (unsigned*)(ws + WS_CTL) + 64; \
            __builtin_amdgcn_fence(__ATOMIC_RELEASE, "agent"); asm volatile("s_waitcnt vmcnt(0)" ::: "memory"); \
            __hip_atomic_fetch_add(ctr_, 1u, __ATOMIC_RELAXED, __HIP_MEMORY_SCOPE_AGENT); \
            const unsigned want_ = nbar * (unsigned)G; unsigned sp_ = 0; \
            while (__hip_atomic_load(ctr_, __ATOMIC_RELAXED, __HIP_MEMORY_SCOPE_AGENT) < want_) { __builtin_amdgcn_s_sleep(2); if (++sp_ > (1u << 23)) break; } \
            __builtin_amdgcn_fence(__ATOMIC_ACQUIRE, "agent"); asm volatile("s_waitcnt vmcnt(0)" ::: "memory"); } \
        __syncthreads(); } while (0)
#ifndef REPEAT_MASK
#define REPEAT_MASK 0
#endif
#define NREP(k) (1 + ((REPEAT_MASK >> (k)) & 1))
    if (args.ph_hi < 0) grid.sync();
#define XBAR ((unsigned*)(ws + WS_CTL) + 2048)
#define PB_GRP (((unsigned)bx & 7u) >> 1)
#define PB_SUB ((unsigned*)(ws + WS_CTL) + 6144)
#define PB_TOP ((unsigned*)(ws + WS_CTL) + 8192)
#define PB_CNT ((unsigned*)(ws + WS_CTL) + 9216)
#define PAIRSEAM(k, slot) do { if (IN(k) && IN((k) + 1)) pair_barrier(PB_SUB + 8u * ((PB_GRP * 16u + xb_xcc_id()) * 4u + (slot)), PB_TOP + 64u * (PB_GRP * 4u + (slot)), pb_nloc, pb_nx, XBAR, mk_tid(wv) == 0); } while (0)
    if (mk_tid(wv) == 0) (void)xb_add(&PB_CNT[PB_GRP * 16u + xb_xcc_id()], 1u);
    if (mk_tid(wv) == 0) (void)xb_add(&XBAR[XB_XCNT(xb_xcc_id())], 1u);
    unsigned pb_nloc = 1u, pb_nx = 1u;
    unsigned xb_nloc = 1u, xb_nx = 1u;
#ifdef PROBE_SEAMWAIT
#define SEAM_PW ((unsigned long long*)(ws + WS_CTL + 65536) + (size_t)bx * 8)
#else
#define SEAM_PW ((unsigned long long*)nullptr)
#endif
#define SEAM(k) do { if (IN(k) && IN((k) + 1)) xcd_barrier_seam(XBAR, xb_xcc_id(), xb_nloc, xb_nx, mk_tid(wv) == 0, (unsigned)(k), SEAM_PW); } while (0)
#define SEAMG(k, gen) do { if (IN(k) && IN((k) + 1)) xcd_barrier_seam(XBAR, xb_xcc_id(), xb_nloc, xb_nx, mk_tid(wv) == 0, (unsigned)(gen), SEAM_PW); } while (0)


    for (int rep_ = 0; rep_ < NREP(0); ++rep_) {
    if (rep_ > 0) { const int k_save = 0; (void)k_save; BARRIER_ONLY(); }
    if (IN(0)) {
        FRESH_TID();
        PrepIn I; I.x = args.in[0]; I.g0 = args.in[1]; I.w0in = args.in[2]; I.w0out = args.in[3]; I.pek = args.in[6]; I.w1k = args.in[7]; I.w2k = args.in[8];
        I.pev = args.in[9]; I.w1v = args.in[10]; I.w2v = args.in[11]; I.g1 = args.in[12]; I.w1in = args.in[13]; I.w1out = args.in[14];
        I.lq1 = args.in[17]; I.lk1 = args.in[18]; I.lq2 = args.in[19]; I.lk2 = args.in[20];
        p0_prep(I, ws, lds3, vcu * 8 + wave, G * 8, wave, lane);
    }
    }
    if (IN(0) && IN(1) && wv == 0) {
        const unsigned xb_x = xb_xcc_id(); unsigned sum_, cnt_, mine_, sp_ = 0u, psum_ = 0u, pcnt_ = 0u, pmine_ = 0u;
        for (;;) { sum_ = 0u; cnt_ = 0u; mine_ = 0u;
#pragma unroll
            for (unsigned j_ = 0; j_ < 16; ++j_) { const unsigned c_ = xb_ld(&XBAR[XB_XCNT(j_)]); sum_ += c_; cnt_ += (c_ > 0u) ? 1u : 0u; mine_ = (j_ == xb_x) ? c_ : mine_; }
            psum_ = 0u; pcnt_ = 0u; pmine_ = 0u;
#pragma unroll
            for (unsigned j_ = 0; j_ < 16; ++j_) { const unsigned c_ = xb_ld(&PB_CNT[PB_GRP * 16u + j_]); psum_ += c_; pcnt_ += (c_ > 0u) ? 1u : 0u; pmine_ = (j_ == xb_x) ? c_ : pmine_; }
            if (sum_ == (unsigned)G && psum_ == (unsigned)(G / 4)) break;
            __builtin_amdgcn_s_sleep(1);
            if ((++sp_ & 255u) == 0u) { if (xb_ld(&XBAR[XB_TMO])) break; if (sp_ > XB_SPIN_CAP) { atomicAdd(&XBAR[XB_TMO], 1u); break; } } }
        xb_nloc = (unsigned)__builtin_amdgcn_readfirstlane((int)(mine_ > 0u ? mine_ : 1u)); xb_nx = (unsigned)__builtin_amdgcn_readfirstlane((int)(cnt_ > 0u ? cnt_ : 1u));
        pb_nloc = (unsigned)__builtin_amdgcn_readfirstlane((int)(pmine_ > 0u ? pmine_ : 1u)); pb_nx = (unsigned)__builtin_amdgcn_readfirstlane((int)(pcnt_ > 0u ? pcnt_ : 1u));
    }
    SEAM(0);
    for (int rep_ = 0; rep_ < NREP(1); ++rep_) {
    if (rep_ > 0) { const int k_save = 0; (void)k_save; BARRIER_ONLY(); }
    if (IN(1)) {
        pg8::Gemm g{(const bf16_t*)(ws + WS_H0), (const bf16_t*)(ws + WS_W0T), MTOK, N0, DM}; pg8::StaticOrder S; S.init(MTOK, N0, G, bx);
        EpiL0In E{ws, args.in[4], args.in[5], EpiCommon{cosT, sinT, (LAS float*)(lds3 + LDS_XT)}};
        pg8::gemm_phase<EpiL0In, pg8::StaticOrder, G_ALIGN_BIG, G_SP2_BIG>(lds3, g, S, E, wv);
        { pg8::Unit ut; int nu = 0; while (S.next(nu, ut)) ++nu;
          const int nunits = (MTOK / 256) * (N0 / 256), maxu = (nunits + G - 1) / G, nidle = maxu * G - nunits;
          const bool sharer = (nidle == 0) || (nu < maxu);
          if (sharer) {
              const int rank = (nidle == 0) ? bx : bx - (G - nidle), nsh = (nidle == 0) ? G : nidle;
              PrepIn I; I.w0out = args.in[3]; I.g1 = args.in[12]; I.w1in = args.in[13]; I.w1out = args.in[14];
              I.x = nullptr; I.g0 = nullptr; I.w0in = nullptr; I.pek = nullptr; I.w1k = nullptr; I.w2k = nullptr; I.pev = nullptr; I.w1v = nullptr; I.w2v = nullptr; I.lq1 = nullptr; I.lk1 = nullptr; I.lq2 = nullptr; I.lk2 = nullptr;
              __syncthreads();
              for (int c = rank; c < CONV_IN_P1; c += nsh) conv_item(I, ws, lds3, c, wv);
          } }
    }
    }
    SEAM(1);
    for (int rep_ = 0; rep_ < NREP(2); ++rep_) {
    if (rep_ > 0) { const int k_save = 0; (void)k_save; BARRIER_ONLY(); }
    if (IN(2)) {
        FRESH_TID();
        unsigned* qctr = (unsigned*)(ws + WS_CTL) + rep_; LAS unsigned* slot = (LAS unsigned*)(lds3 + LDS_BYTES - 16);
        for (;;) {
            __syncthreads();
            if (tid == 0) *slot = atomicAdd(qctr, 1u);
            __syncthreads();
            const unsigned qi = *slot;
            if (qi >= (unsigned)NQITEMS) break;
            const unsigned code = P3_ITEMS.v[qi];
            if (!(code & 0x1000u) && (PVAR & ((code & 0x2000u) ? 0x100 : (code & 0xC000u) ? 0x200 : 0x400))) continue;
            if (code & 0x1000u) { compress_item(ws, args.in[5], args.in[6], args.in[9], lds, (int)(code & 0xfffu), wv); continue; }
            if (code & 0x2000u) {
                PrepIn I; I.w0out = args.in[3]; I.g1 = args.in[12]; I.w1in = args.in[13]; I.w1out = args.in[14];
                I.x = nullptr; I.g0 = nullptr; I.w0in = nullptr; I.pek = nullptr; I.w1k = nullptr; I.w2k = nullptr; I.pev = nullptr; I.w1v = nullptr; I.w2v = nullptr; I.lq1 = nullptr; I.lk1 = nullptr; I.lq2 = nullptr; I.lk2 = nullptr;
                conv_item(I, ws, lds3, (int)(code & 0x1fffu), wv);
            } else if (code & 0xC000u) {
                const int bh = (code >> 3) & 31, qb = code & 7, h = bh & 7;
                constexpr float LG0 = (float)log2_1m(pow2neg(5)), LG1 = (float)log2_1m(pow2neg(6)), LG2 = (float)log2_1m(pow2neg(7)), LG3 = (float)log2_1m(pow2neg(8));
                constexpr float LG4 = (float)log2_1m(pow2neg(9)), LG5 = (float)log2_1m(pow2neg(10)), LG6 = (float)log2_1m(pow2neg(11)), LG7 = (float)log2_1m(pow2neg(12));
                const float lg = h == 0 ? LG0 : h == 1 ? LG1 : h == 2 ? LG2 : h == 3 ? LG3 : h == 4 ? LG4 : h == 5 ? LG5 : h == 6 ? LG6 : LG7;
#ifndef P3_NO_RET
                if (code & 0x4000u) kv_unit(ws, lds, bh, qb, lg, wv); else ret_unit(ws, lds, bh, qb, lg, wv);
#endif
            } else {
#ifndef P3_NO_NSA
                nsa_unit(ws, lds, (code >> 5) & 7, code & 31, (code >> 8) & 3, wv);
#endif
            }
        }
    }
    }
    SEAM(2);
    for (int rep_ = 0; rep_ < NREP(3); ++rep_) {
    if (rep_ > 0) { const int k_save = 0; (void)k_save; BARRIER_ONLY(); }
    if (IN(3)) {
        pg8::Gemm g{(const bf16_t*)(ws + WS_Y0), (const bf16_t*)(ws + WS_W0OT), MTOK, DM, DM}; pg8::StaticOrder S; S.init(MTOK, DM, G, bx);
        EpiL0Out E{args.in[0], (bf16_t*)(ws + WS_X1B), (float*)(ws + WS_RSS1)};
        pg8::gemm_phase<EpiL0Out, pg8::StaticOrder, G_ALIGN_ONE, G_SP2_ONE>(lds3, g, S, E, wv);
    }
    }
    PAIRSEAM(3, 0u);
    for (int rep_ = 0; rep_ < NREP(4); ++rep_) {
    if (rep_ > 0) { const int k_save = 0; (void)k_save; BARRIER_ONLY(); }
    if (IN(4)) {
        pg8::Gemm g{(const bf16_t*)(ws + WS_X1B), (const bf16_t*)(ws + WS_W1T), MTOK, N1, DM}; pg8::StaticOrder S; S.init(MTOK, N1, G, bx);
        LAS float* rsl = (LAS float*)(lds3 + LDS_RS);
        FRESH_TID();
        { pg8::Unit u; const float* rss = (const float*)(ws + WS_RSS1);
          f32x4 pv[4][8]; bool have[4];
#pragma unroll
          for (int i = 0; i < 4; ++i) { have[i] = S.next(i, u);
              if (have[i] && tid < 256) { const f32x4* p = (const f32x4*)(rss + (size_t)(u.pm * 256 + tid) * 32);
#pragma unroll
                  for (int j = 0; j < 8; ++j) pv[i][j] = p[j]; } }
#pragma unroll
          for (int i = 0; i < 4; ++i) { if (have[i] && tid < 256) { float s = 0.f;
#pragma unroll
                  for (int j = 0; j < 8; ++j) { const f32x4 v = pv[i][j]; s += (v[0] + v[1]) + (v[2] + v[3]); }
                  rsl[i * 256 + tid] = 1.0f / sqrtf(s * (1.0f / DM) + EPS); } }
          __syncthreads(); }
        EpiL1In E{ws, args.in[15], args.in[16], EpiCommon{cosT, sinT, (LAS float*)(lds3 + LDS_XT)}, rsl, (PVAR & 0x800) ? 1 : 0};
        pg8::gemm_phase<EpiL1In, pg8::StaticOrder, G_ALIGN_BIG, G_SP2_BIG>(lds3, g, S, E, wv);
    }
    }
    PAIRSEAM(4, 2u);
    for (int rep_ = 0; rep_ < NREP(5); ++rep_) {
    if (rep_ > 0) { const int k_save = 0; (void)k_save; BARRIER_ONLY(); }
    if (IN(5)) {
        const float lam = *(const float*)(ws + WS_LAM);
        for (int id = bx; id < 256; id += G) {
            const int xcd = id & 7, slot = id >> 3, bhh = xcd * 4 + (slot >> 3), sub = slot & 7, cc = sub & 1, pr = sub >> 1;
#pragma unroll 1
            for (int k = 0; k < 2; ++k) diff_unit(ws, (unsigned char*)args.out + (size_t)(bhh >> 3) * ((size_t)8 << 20), lds, bhh >> 3, bhh & 7, cc, k ? pr : 7 - pr, lam, (cc ^ k) == 0, wv, PVAR);
        }
    }
    }
    PAIRSEAM(5, 1u);
    if (IN(6)) {
        pg8::Gemm g{(const bf16_t*)(ws + WS_Y1), (const bf16_t*)(ws + WS_W1OT), MTOK, DM, DM}; pg8::StaticOrder S; S.init(MTOK, DM, G, bx);
        EpiL1Out E{args.out, (const bf16_t*)(ws + WS_X1B)};
        pg8::gemm_phase<EpiL1Out, pg8::StaticOrder, G_ALIGN_ONE, G_SP2_ONE>(lds3, g, S, E, wv);
    }
#ifdef PROBE_SEAMWAIT
    xcd_barrier_seam(XBAR, xb_xcc_id(), xb_nloc, xb_nx, mk_tid(wv) == 0, 4u, nullptr);
    if (bx == 0 && mk_tid(wv) == 0) {
        const unsigned long long* pwa = (const unsigned long long*)(ws + WS_CTL + 65536); unsigned long long sum_ = 0;
#ifndef PROBE_WGLO
#define PROBE_WGLO 0
#define PROBE_WGHI G
#endif
#ifndef PROBE_WGMASK
#define PROBE_WGMASK 0
#define PROBE_WGVAL 0
#endif
        unsigned cnt_w = 0;
        for (int w_ = PROBE_WGLO; w_ < PROBE_WGHI; ++w_) if ((w_ & PROBE_WGMASK) == PROBE_WGVAL) { ++cnt_w; for (int k_ = 0; k_ < 6; ++k_) if ((PROBE_SEAMWAIT >> k_) & 1) sum_ += pwa[(size_t)w_ * 8 + k_]; }
        const unsigned long long tgt_ = __builtin_amdgcn_s_memtime() + 8ull * (sum_ / (unsigned long long)(cnt_w ? cnt_w : 1u));
        while (__builtin_amdgcn_s_memtime() < tgt_) __builtin_amdgcn_s_sleep(8);
    }
#endif
#undef IN
#undef SEAM
}


#ifdef DEBUG_SCAN
__global__ void scan_bf16(const unsigned short* p, size_t n, unsigned* flags, unsigned bit) {
    unsigned bad = 0;
    for (size_t i = (size_t)blockIdx.x * blockDim.x + threadIdx.x; i < n; i += (size_t)gridDim.x * blockDim.x) { const unsigned v = p[i]; if ((v & 0x7f80u) == 0x7f80u) bad = 1; }
    if (bad) atomicOr(flags, bit);
}
__global__ void scan_cols(const unsigned short* p, size_t rows, int stride, int c0, int c1, unsigned* flags, unsigned bit) {
    unsigned bad = 0; const int w = c1 - c0;
    for (size_t i = (size_t)blockIdx.x * blockDim.x + threadIdx.x; i < rows * w; i += (size_t)gridDim.x * blockDim.x) { const unsigned v = p[(i / w) * stride + c0 + (i % w)]; if ((v & 0x7f80u) == 0x7f80u) bad = 1; }
    if (bad) atomicOr(flags, bit);
}
__global__ void scan_f32(const float* p, size_t n, unsigned* flags, unsigned bit) {
    unsigned bad = 0;
    for (size_t i = (size_t)blockIdx.x * blockDim.x + threadIdx.x; i < n; i += (size_t)gridDim.x * blockDim.x) { const unsigned v = __float_as_uint(p[i]); if ((v & 0x7f800000u) == 0x7f800000u) bad = 1; }
    if (bad) atomicOr(flags, bit);
}
__global__ void dbg_final(float* out, size_t n, const unsigned* flags) {
    const unsigned f = *flags; float off = 0.f;
    if (f) { int k = 0; while (!((f >> k) & 1u)) ++k; off = (float)(k + 1); }
    for (size_t i = (size_t)blockIdx.x * blockDim.x + threadIdx.x; i < n; i += (size_t)gridDim.x * blockDim.x) { float v = out[i]; if ((__float_as_uint(v) & 0x7f800000u) == 0x7f800000u) v = 0.f; out[i] = v + off; }
}
#endif

#ifdef DEBUG_NSA
__global__ void __launch_bounds__(512) check_nsa(const unsigned char* ws, unsigned* res) {
    __shared__ float q[4][128]; __shared__ float sc[4][2048]; __shared__ float pc[4][128]; __shared__ float imp[32]; __shared__ float red[4][128]; __shared__ unsigned selmask;
    __shared__ float ocmp[4][128], oslc[4][128];
    const int smp = blockIdx.x, tid = threadIdx.x, r = tid >> 7, d = tid & 127;
    const int b = smp & 3, g = (smp >> 2) & 1;
    const int tl[16] = {0, 5, 30, 31, 47, 63, 64, 511, 512, 513, 1023, 1024, 1500, 1983, 1984, 2047};
    const int t = (smp >> 3) < 16 ? tl[smp >> 3] : ((smp * 977 + 131) & 2047);
    const int bg = b * 2 + g, hq = g * 4 + r;
    const unsigned short* NQ = (const unsigned short*)(ws + WS_NQ) + ((size_t)(b * 8 + hq) * SEQ + t) * 128;
    q[r][d] = bf2f(NQ[d]); __syncthreads();
    auto blockmax = [&](float v) { red[r][d] = v; __syncthreads(); for (int s = 64; s > 0; s >>= 1) { if (d < s) red[r][d] = fmaxf(red[r][d], red[r][d + s]); __syncthreads(); } float m = red[r][0]; __syncthreads(); return m; };
    auto blocksum = [&](float v) { red[r][d] = v; __syncthreads(); for (int s = 64; s > 0; s >>= 1) { if (d < s) red[r][d] += red[r][d + s]; __syncthreads(); } float m = red[r][0]; __syncthreads(); return m; };
    const unsigned short* KC = (const unsigned short*)(ws + WS_KCMP) + (size_t)bg * 128 * 128; const unsigned short* VC = (const unsigned short*)(ws + WS_VCMP) + (size_t)bg * 128 * 128;
    float s = -INFINITY;
    if (d < 127 && 16 * d + 31 <= t) { float a = 0.f; for (int k = 0; k < 128; ++k) a += q[r][k] * bf2f(KC[d * 128 + k]); s = a * RSQRT_HD; }
    float m = blockmax(s); float p = (s == -INFINITY) ? 0.f : expf(s - m); float l = blocksum(p); p = l > 0.f ? p / l : 0.f; pc[r][d] = p; __syncthreads();
    { float a = 0.f; for (int n = 0; n < 127; ++n) a += pc[r][n] * bf2f(VC[n * 128 + d]); ocmp[r][d] = a; }
    if (tid < 32) { float a = 0.f; for (int rr = 0; rr < 4; ++rr) for (int n = 4 * tid - 1; n <= 4 * tid + 3; ++n) if (n >= 0 && n < 127) a += pc[rr][n]; imp[tid] = a; }
    __syncthreads();
    if (tid == 0) { const int bt = t >> 6; float scv[32]; unsigned msk = 0;
        for (int j = 0; j < 32; ++j) { const int back = bt - j; const bool forced = (j == 0) || (back >= 0 && back < 2); scv[j] = forced ? 1e9f : (back >= 0 ? imp[j] : -1e9f); }
        for (int j = 0; j < 32; ++j) { int rank = 0; for (int i = 0; i < 32; ++i) rank += (scv[i] > scv[j] || (scv[i] == scv[j] && i < j)) ? 1 : 0; if (rank < 16) msk |= 1u << j; }
        selmask = msk; }
    __syncthreads();
    const unsigned short* KS = (const unsigned short*)(ws + WS_KS) + (size_t)bg * SEQ * 128; const unsigned short* VS = (const unsigned short*)(ws + WS_VS) + (size_t)bg * SEQ * 128;
    float mx = -INFINITY;
    for (int k = d; k < SEQ; k += 128) { float v = -INFINITY; if (k <= t && ((selmask >> (k >> 6)) & 1u)) { float a = 0.f; for (int e = 0; e < 128; ++e) a += q[r][e] * bf2f(KS[(size_t)k * 128 + e]); v = a * RSQRT_HD; } sc[r][k] = v; mx = fmaxf(mx, v); }
    m = blockmax(mx); float ls = 0.f;
    for (int k = d; k < SEQ; k += 128) { const float v = sc[r][k]; const float e = (v == -INFINITY) ? 0.f : expf(v - m); sc[r][k] = e; ls += e; }
    l = blocksum(ls);
    { float a = 0.f; for (int k = 0; k <= t; ++k) a += sc[r][k] * bf2f(VS[(size_t)k * 128 + d]); oslc[r][d] = a / l; }
    __syncthreads();
    const unsigned short* KW = (const unsigned short*)(ws + WS_KW) + (size_t)bg * SEQ * 128; const unsigned short* VW = (const unsigned short*)(ws + WS_VW) + (size_t)bg * SEQ * 128;
    mx = -INFINITY;
    for (int k = d; k < SEQ; k += 128) { float v = -INFINITY; if (k <= t && t - k < 512) { float a = 0.f; for (int e = 0; e < 128; ++e) a += q[r][e] * bf2f(KW[(size_t)k * 128 + e]); v = a * RSQRT_HD; } sc[r][k] = v; mx = fmaxf(mx, v); }
    m = blockmax(mx); ls = 0.f;
    for (int k = d; k < SEQ; k += 128) { const float v = sc[r][k]; const float e = (v == -INFINITY) ? 0.f : expf(v - m); sc[r][k] = e; ls += e; }
    l = blocksum(ls);
    float ow = 0.f; for (int k = 0; k <= t; ++k) ow += sc[r][k] * bf2f(VW[(size_t)k * 128 + d]); ow /= l;
    const float* gt = (const float*)(ws + WS_GATES) + ((size_t)b * SEQ + t) * 24 + hq;
    const float sg = bf2f(((const unsigned short*)(ws + WS_SNG))[((size_t)b * SEQ + t) * 1024 + hq * 128 + d]);
#ifndef CHK_BRANCH
#define CHK_BRANCH 7
#endif
    const float yref = (gt[0] * ocmp[r][d] + gt[8] * oslc[r][d] + gt[16] * ow) * sg;
    const float yfast = bf2f(((const unsigned short*)(ws + WS_Y0))[((size_t)b * SEQ + t) * DM + 1024 + hq * 128 + d]);
    const float e2 = blocksum((yfast - yref) * (yfast - yref)), n2 = blocksum(yref * yref);
    if (d == 0 && e2 > 0.03f * 0.03f * n2 + 1e-12f) atomicAdd(res, 1u);
}
__global__ void dbg_final2(float* out, size_t n, const unsigned* res) {
    const float off = 0.1f * (float)(*res);
    for (size_t i = (size_t)blockIdx.x * blockDim.x + threadIdx.x; i < n; i += (size_t)gridDim.x * blockDim.x) out[i] += off;
}
#endif
#ifndef MK_ONE_LAUNCH
#define MK_ONE_LAUNCH 1
#endif
extern "C" void kernel_launch(void* const* d_in, const int* in_sizes, int n_in, void* d_out, int out_size, void* d_ws, size_t ws_size, hipStream_t stream) {
    static int grid = 0;
    if (grid == 0) {
        if (n_in != 21 || out_size != MTOK * DM || ws_size < WS_END) { fprintf(stderr, "kernel_launch: unexpected shapes (n_in %d out %d ws %zu)\n", n_in, out_size, ws_size); grid = -1; return; }
        int dev = 0, cus = 0, per_cu = 0;
        if (hipGetDevice(&dev) != hipSuccess || hipDeviceGetAttribute(&cus, hipDeviceAttributeMultiprocessorCount, dev) != hipSuccess) { grid = -1; return; }
        if (hipFuncSetAttribute((const void*)mega_fwd, hipFuncAttributeMaxDynamicSharedMemorySize, LDS_BYTES) != hipSuccess) { fprintf(stderr, "kernel_launch: hipFuncSetAttribute failed\n"); grid = -1; return; }
        if (hipOccupancyMaxActiveBlocksPerMultiprocessor(&per_cu, (const void*)mega_fwd, 512, LDS_BYTES) != hipSuccess || per_cu < 1) { fprintf(stderr, "kernel_launch: occupancy query says %d\n", per_cu); per_cu = 1; }
        (void)hipGetLastError();
        grid = cus * 1;
        if (grid % 16 != 0) { fprintf(stderr, "kernel_launch: grid %d is not a multiple of 16 (the differential-attention partner wait needs that)\n", grid); grid = -1; return; }
        fprintf(stderr, "kernel_launch: grid %d (cus %d, per_cu %d)\n", grid, cus, per_cu);
    }
    if (grid < 0) return;
    (void)hipMemsetAsync((char*)d_ws + WS_CTL, 0, CTL_BYTES, stream);
    Args a{};
    for (int i = 0; i < 21; ++i) a.in[i] = (const float*)d_in[i];
    a.out = (float*)d_out; a.ws = (unsigned char*)d_ws;
#if MK_ONE_LAUNCH
    a.ph_lo = 0; a.ph_hi = NPHASE;
    void* kargs[] = {&a};
    hipError_t e = hipLaunchCooperativeKernel((const void*)mega_fwd, dim3(grid), dim3(512), kargs, LDS_BYTES, stream);
    if (e != hipSuccess) fprintf(stderr, "kernel_launch: cooperative launch failed: %s\n", hipGetErrorString(e));
#else
    for (int p = 0; p < NPHASE; ++p) { a.ph_lo = p; a.ph_hi = p + 1;
#ifdef ML_REPEAT
#ifdef PROBE_VAR
        if (p == ML_REPEAT) { Args a2 = a; a2.variant = PROBE_VAR; hipLaunchKernelGGL(mega_fwd, dim3(grid), dim3(512), LDS_BYTES, stream, a2); (void)hipMemsetAsync((char*)d_ws + WS_CTL, 0, CTL_BYTES, stream); }
        hipLaunchKernelGGL(mega_fwd, dim3(grid), dim3(512), LDS_BYTES, stream, a);
#else
        hipLaunchKernelGGL(mega_fwd, dim3(grid), dim3(512), LDS_BYTES, stream, a);
        if (p == ML_REPEAT) { (void)hipMemsetAsync((char*)d_ws + WS_CTL, 0, CTL_BYTES, stream); hipLaunchKernelGGL(mega_fwd, dim3(grid), dim3(512), LDS_BYTES, stream, a); }
#endif
#else
        hipLaunchKernelGGL(mega_fwd, dim3(grid), dim3(512), LDS_BYTES, stream, a);
#endif
#ifdef DEBUG_NSA
        if (p == 2) check_nsa<<<256, 512, 0, stream>>>((const unsigned char*)d_ws, (unsigned*)((unsigned char*)d_ws + WS_CTL) + 200);
        if (p == 6) dbg_final2<<<256, 512, 0, stream>>>((float*)d_out, (size_t)MTOK * DM, (const unsigned*)((unsigned char*)d_ws + WS_CTL) + 200);
#endif
#ifdef DEBUG_SCAN
        unsigned char* w = (unsigned char*)d_ws; unsigned* fl = (unsigned*)(w + WS_CTL) + 128;
        if (p == 0) { scan_bf16<<<256, 512, 0, stream>>>((const unsigned short*)(w + WS_H0), (size_t)MTOK * DM, fl, 1u);
                      scan_bf16<<<256, 512, 0, stream>>>((const unsigned short*)(w + WS_W0T), (size_t)N0 * DM, fl, 1u);
                      scan_f32<<<256, 512, 0, stream>>>((const float*)(w + WS_COS), (size_t)SEQ * 128, fl, 1u); }
        if (p == 1) { scan_bf16<<<256, 512, 0, stream>>>((const unsigned short*)(w + WS_L0), (size_t)60 * MiB, fl, 2u); scan_f32<<<256, 512, 0, stream>>>((const float*)(w + WS_GATES), (size_t)MTOK * 24, fl, 2u); }
        if (p == 2) { scan_bf16<<<256, 512, 0, stream>>>((const unsigned short*)(w + WS_KCMP), (size_t)2 * 8 * 128 * 128, fl, 4u); }
        if (p == 3) { for (int hh = 0; hh < 8; ++hh) scan_cols<<<256, 512, 0, stream>>>((const unsigned short*)(w + WS_Y0), MTOK, DM, hh * 128, hh * 128 + 128, fl, 1u << hh); }
        if (p == 4) { scan_bf16<<<256, 512, 0, stream>>>((const unsigned short*)(w + WS_X1B), (size_t)MTOK * DM, fl, 16u); }
        if (p == 5) { scan_bf16<<<256, 512, 0, stream>>>((const unsigned short*)(w + WS_Q1), (size_t)MTOK * DM, fl, 32u); scan_bf16<<<256, 512, 0, stream>>>((const unsigned short*)(w + WS_K1), (size_t)MTOK * DM, fl, 32u);
                      scan_bf16<<<256, 512, 0, stream>>>((const unsigned short*)(w + WS_V1), (size_t)MTOK * DM * 2, fl, 32u); }
        if (p == 6) { scan_bf16<<<256, 512, 0, stream>>>((const unsigned short*)(w + WS_OD), (size_t)MTOK * DM, fl, 64u); }
        if (p == 7) { dbg_final<<<256, 512, 0, stream>>>((float*)d_out, (size_t)MTOK * DM, fl + 1); }
#endif
    }
#endif
}
```
